# Optimizing an MI355X kernel written in HIP

```python
import math
import jax, jax.numpy as jnp
from jax import lax
import numpy as np

D_MODEL = 1024
BATCH = 16
SEQ = 2048
DEPTH = 4

CHUNK = 64
Q_BLOCK = 128
N_A = DEPTH // 2
N_B = DEPTH - N_A
EXPAND_A = 2
E_A = EXPAND_A * D_MODEL
POOL_WINDOWS = (2, 4, 8, 16)
N_POOL_GROUPS = len(POOL_WINDOWS)
G_A = E_A // N_POOL_GROUPS
N_HEADS_B = D_MODEL // 128
HEAD_DIM_B = 64
V_DIM_B = 2 * HEAD_DIM_B
QK_B = N_HEADS_B * 2 * HEAD_DIM_B
E_B = N_HEADS_B * V_DIM_B
EPS = 1e-6
SUBLN_EPS = 1e-5

kernel_name = "hybrid_pool_diffattn_yoco_trunk"


def lambda_init_fn(layer_idx):
    return 0.8 - 0.6 * math.exp(-0.3 * layer_idx)


def rms_norm(x, g, eps=EPS):
    xf = x.astype(jnp.float32)
    y = xf * lax.rsqrt(jnp.mean(xf * xf, axis=-1, keepdims=True) + eps)
    return (y * g.astype(jnp.float32)).astype(x.dtype)


def modulate(h, shift, scale):
    return h * (1.0 + scale[:, None, :]) + shift[:, None, :]


def pool_mixer(h, w_in, w_group, ch_scale, w_out):
    B, S, _ = h.shape
    u, z = jnp.split(h @ w_in, 2, axis=-1)
    uf = u.astype(jnp.float32).reshape(B, S, N_POOL_GROUPS, G_A)
    cs = jnp.cumsum(uf, axis=1)
    cs = jnp.concatenate([jnp.zeros_like(cs[:, :1]), cs], axis=1)
    t = jnp.arange(S)
    pooled = []
    for g, w in enumerate(POOL_WINDOWS):
        lo = jnp.maximum(t + 1 - w, 0)
        cnt = jnp.minimum(t + 1, w).astype(jnp.float32)
        win_sum = cs[:, 1:, g] - jnp.take(cs[:, :, g], lo, axis=1)
        pooled.append(win_sum / cnt[None, :, None])
    pooled = jnp.stack(pooled, axis=2) - uf
    mixed = jnp.einsum('bsgi,gio->bsgo', pooled.astype(u.dtype), w_group)
    mixed = mixed.reshape(B, S, E_A) * ch_scale
    return (mixed * jax.nn.silu(z)) @ w_out


def shared_kv(x, kv_norm, kv_shift, kv_scale, w_kv):
    B, S, _ = x.shape
    hk = modulate(rms_norm(x, kv_norm), kv_shift, kv_scale)
    kv = hk @ w_kv
    k = kv[..., :QK_B].reshape(B, S, N_HEADS_B, 2, HEAD_DIM_B)
    v = kv[..., QK_B:].reshape(B, S, N_HEADS_B, V_DIM_B)
    return k, v


def diff_attention(h, k, v, w_in, lam_vec, subln_g, w_out, lam_init):
    B, S, _ = h.shape
    q, z = jnp.split(h @ w_in, 2, axis=-1)
    q = q.reshape(B, S, N_HEADS_B, 2, HEAD_DIM_B)
    lv = lam_vec.astype(jnp.float32)
    lam = jnp.exp(jnp.sum(lv[0] * lv[1])) - jnp.exp(jnp.sum(lv[2] * lv[3])) + lam_init
    n_blk = S // Q_BLOCK
    qb = q.reshape(B, n_blk, Q_BLOCK, N_HEADS_B, 2, HEAD_DIM_B).transpose(1, 0, 2, 3, 4, 5)
    key_chunk = jnp.arange(S) // CHUNK
    sm_scale = HEAD_DIM_B ** -0.5

    def block(args):
        q_i, i = args
        s = jnp.einsum('bqhcd,bkhcd->bhcqk', q_i, k).astype(jnp.float32) * sm_scale
        q_chunk = (i * Q_BLOCK + jnp.arange(Q_BLOCK)) // CHUNK
        mask = key_chunk[None, :] <= q_chunk[:, None]
        p = jax.nn.softmax(jnp.where(mask, s, -jnp.inf), axis=-1)
        a = p[:, :, 0] - lam * p[:, :, 1]
        return jnp.einsum('bhqk,bkhv->bqhv', a.astype(v.dtype), v)

    o = lax.map(block, (qb, jnp.arange(n_blk)))
    o = o.transpose(1, 0, 2, 3, 4).reshape(B, S, N_HEADS_B, V_DIM_B)
    o = rms_norm(o, subln_g, SUBLN_EPS) * (1.0 - lam_init)
    y = o.reshape(B, S, E_B) * jax.nn.silu(z)
    return y @ w_out


def setup_inputs(seed: int = 0) -> dict:
    key = jax.random.key(seed)
    ks = jax.random.split(key, 20)
    f32 = jnp.float32
    D = D_MODEL

    def nrm(k, shape, s):
        return jax.random.normal(k, shape, f32) * s

    return {
        "x": nrm(ks[0], (BATCH, SEQ, D), 1.0),
        "c": nrm(ks[1], (BATCH, D), 1.0),
        "ada_w": nrm(ks[2], (DEPTH, D, 3 * D), 0.5 * D ** -0.5),
        "ada_b": nrm(ks[3], (DEPTH, 3 * D), 0.02),
        "norm_pre": 1.0 + nrm(ks[4], (DEPTH, D), 0.05),
        "norm_post": 1.0 + nrm(ks[5], (DEPTH, D), 0.05),
        "a_w_in": nrm(ks[6], (N_A, D, 2 * E_A), D ** -0.5),
        "a_w_group": nrm(ks[7], (N_A, N_POOL_GROUPS, G_A, G_A), G_A ** -0.5),
        "a_scale": 1.0 + nrm(ks[8], (N_A, E_A), 0.1),
        "a_w_out": nrm(ks[9], (N_A, E_A, D), E_A ** -0.5),
        "kv_norm": 1.0 + nrm(ks[10], (D,), 0.05),
        "kv_ada_w": nrm(ks[11], (D, 2 * D), 0.5 * D ** -0.5),
        "kv_ada_b": nrm(ks[12], (2 * D,), 0.02),
        "w_kv": nrm(ks[13], (D, QK_B + E_B), D ** -0.5),
        "b_w_in": nrm(ks[14], (N_B, D, QK_B + E_B), D ** -0.5),
        "b_lambda": nrm(ks[15], (N_B, 4, HEAD_DIM_B), 0.1),
        "b_subln": 1.0 + nrm(ks[16], (N_B, V_DIM_B), 0.05),
        "b_w_out": nrm(ks[17], (N_B, E_B, D), E_B ** -0.5),
    }


def reference(x, c, ada_w, ada_b, norm_pre, norm_post, a_w_in, a_w_group, a_scale,
              a_w_out, kv_norm, kv_ada_w, kv_ada_b, w_kv, b_w_in, b_lambda, b_subln,
              b_w_out):
    cond = jax.nn.silu(c)
    k = v = None
    for l in range(DEPTH):
        shift, scale, gate = jnp.split(cond @ ada_w[l] + ada_b[l], 3, axis=-1)
        h = modulate(rms_norm(x, norm_pre[l]), shift, scale)
        if l < N_A:
            y = pool_mixer(h, a_w_in[l], a_w_group[l], a_scale[l], a_w_out[l])
        else:
            if l == N_A:
                kv_shift, kv_scale = jnp.split(cond @ kv_ada_w + kv_ada_b, 2, axis=-1)
                k, v = shared_kv(x, kv_norm, kv_shift, kv_scale, w_kv)
            j = l - N_A
            y = diff_attention(h, k, v, b_w_in[j], b_lambda[j], b_subln[j], b_w_out[j],
                               lambda_init_fn(l))
        x = x + gate[:, None, :] * rms_norm(y, norm_post[l])
    return x
```

```cpp
#include <hip/hip_runtime.h>
#include <hip/hip_cooperative_groups.h>
#include <cstdio>
#include <cstdint>
#include <cmath>
namespace cg = cooperative_groups;

#define LAS __attribute__((address_space(3)))
typedef unsigned short bf16_t;
typedef short bf16x8 __attribute__((ext_vector_type(8)));
typedef short s16x4 __attribute__((ext_vector_type(4)));
typedef float f32x4 __attribute__((ext_vector_type(4)));
typedef float f32x16 __attribute__((ext_vector_type(16)));
typedef unsigned u32x4 __attribute__((ext_vector_type(4)));
typedef unsigned u32x2 __attribute__((ext_vector_type(2)));

constexpr int M = 32768, D = 1024, SEQ = 2048, NB = 16;
constexpr float EPS = 1e-6f, SUBLN_EPS = 1e-5f;
constexpr float C2 = 0.125f * 1.4426950408889634f;

constexpr size_t MiB = 1u << 20;
constexpr size_t WS_WA = 0;
constexpr size_t WS_WOUT = 16 * MiB;
constexpr size_t WS_WKV = 24 * MiB;
constexpr size_t WS_WBIN = 28 * MiB;
constexpr size_t WS_WBOUT = 36 * MiB;
constexpr size_t WS_ADA = 40 * MiB;
constexpr size_t WS_KVADA = 41 * MiB;
constexpr size_t WS_CTL = 44 * MiB;
constexpr size_t CTL_BYTES = 65536;
constexpr size_t WS_H5 = 48 * MiB;
constexpr size_t SLOT = 64 * MiB;
constexpr size_t WS_GW = 368 * MiB;
constexpr size_t WS_WU = WS_GW;
constexpr size_t WS_WGT = WS_GW + 8 * MiB;
constexpr size_t WS_END = 496 * MiB;
constexpr int LDS_MISC = 131072;
constexpr int LDS_BYTES = 131072 + 256;

typedef float f32x2_t __attribute__((ext_vector_type(2))); typedef __bf16 bf16x2_t __attribute__((ext_vector_type(2)));
__device__ __forceinline__ unsigned cvt_pk_bf16(float lo, float hi) { const f32x2_t v = {lo, hi}; const bf16x2_t b = __builtin_convertvector(v, bf16x2_t); return __builtin_bit_cast(unsigned, b); }
__device__ __forceinline__ float bf_lo(unsigned w) { return __uint_as_float(w << 16); }
__device__ __forceinline__ float bf_hi(unsigned w) { return __uint_as_float(w & 0xffff0000u); }
template <int CTRL, int RMASK> __device__ __forceinline__ float dpp_add(float v) {
    const int r = __builtin_amdgcn_update_dpp(0, __float_as_int(v), CTRL, RMASK, 0xF, false);
    return v + __int_as_float(r);
}
__device__ __forceinline__ float wave_sum(float v) {
    v = dpp_add<0xB1, 0xF>(v);
    v = dpp_add<0x4E, 0xF>(v);
    v = dpp_add<0x141, 0xF>(v);
    v = dpp_add<0x140, 0xF>(v);
    v = dpp_add<0x142, 0xA>(v);
    v = dpp_add<0x143, 0xC>(v);
    return __int_as_float(__builtin_amdgcn_readlane(__float_as_int(v), 63));
}
__device__ __forceinline__ float silu_f(float v) { return v * __builtin_amdgcn_rcpf(1.0f + __builtin_amdgcn_exp2f(-1.4426950408889634f * v)); }

namespace pg8 {
constexpr int BM = 256, BK = 64, HALF = 128, HTB = HALF * BK * 2, STAGE_BYTES = 8 * HTB;
__host__ __device__ __forceinline__ int lds_byte(int r, int c) { const int st = (r >> 4) * 2 + (c >> 5), rr = r & 15, cc = c & 31, ob = rr * 64 + cc * 2; return st * 1024 + (ob ^ (((ob >> 9) & 1) << 5)); }
__host__ __device__ __forceinline__ void stage_rc(int b, int& R, int& C) { const int st = b / 1024, sb = b % 1024, swz = sb ^ (((sb >> 9) & 1) << 5); R = (st >> 1) * 16 + swz / 64; C = (st & 1) * 32 + (swz % 64) / 2; }
__host__ __device__ __forceinline__ int perm32(int rho) { const int n = rho >> 4, i = rho & 15; return 8 * (i >> 2) + 4 * n + (i & 3); }

struct Unit { const char* A; const char* B; bf16_t* O; const float* aux; int ldc; float scale; int mode; int bjs; };

__device__ __forceinline__ void epilogue(const f32x4 (&acc)[2][2][4][2], const Unit& u, int wr, int wc, int fr, int fq) {
    const int col0 = wc * 32 + 8 * fq;
    f32x4 av[2][2];
    if (u.mode == 2) {
#pragma unroll
        for (int bj = 0; bj < 2; ++bj)
#pragma unroll
            for (int n = 0; n < 2; ++n) av[bj][n] = *(const f32x4*)(u.aux + col0 + bj * HALF + 4 * n);
    }
#pragma unroll
    for (int ai = 0; ai < 2; ++ai)
#pragma unroll
        for (int m = 0; m < 4; ++m) {
            bf16_t* rowp = u.O + (size_t)(ai * HALF + wr * 64 + m * 16 + fr) * u.ldc + col0;
#pragma unroll
            for (int bj = 0; bj < 2; ++bj) {
                f32x4 v0 = acc[ai][bj][m][0], v1 = acc[ai][bj][m][1];
                if (u.mode == 0) { v0 = v0 * u.scale; v1 = v1 * u.scale; }
                else if (u.mode == 1) {
#pragma unroll
                    for (int e = 0; e < 4; ++e) { v0[e] = silu_f(v0[e]); v1[e] = silu_f(v1[e]); }
                } else {
                    const u32x4 g = *(const u32x4*)(rowp + (size_t)bj * u.bjs);
                    v0 = v0 * av[bj][0]; v1 = v1 * av[bj][1];
                    v0[0] *= bf_lo(g.x); v0[1] *= bf_hi(g.x); v0[2] *= bf_lo(g.y); v0[3] *= bf_hi(g.y);
                    v1[0] *= bf_lo(g.z); v1[1] *= bf_hi(g.z); v1[2] *= bf_lo(g.w); v1[3] *= bf_hi(g.w);
                }
                u32x4 w; w.x = cvt_pk_bf16(v0[0], v0[1]); w.y = cvt_pk_bf16(v0[2], v0[3]); w.z = cvt_pk_bf16(v1[0], v1[1]); w.w = cvt_pk_bf16(v1[2], v1[3]);
                *(u32x4*)(rowp + (size_t)bj * u.bjs) = w;
            }
        }
}

template <class Sched>
__device__ __forceinline__ void gemm_phase(LAS unsigned char* lds, const int K, const Sched& S) {
    const int tid = threadIdx.x, wid = __builtin_amdgcn_readfirstlane(tid >> 6), lane = tid & 63, wr = wid >> 2, wc = wid & 3, fr = lane & 15, fq = lane >> 4;
    const int nt = K / BK;
    unsigned voffA[2], voffB[2];
#pragma unroll
    for (int i = 0; i < 2; ++i) { int R, C; stage_rc(tid * 16 + i * 8192, R, C); const int Rb = (R & ~31) + perm32(R & 31);
        voffA[i] = (unsigned)(R * K + C) * 2u; voffB[i] = (unsigned)(Rb * K + C) * 2u; }
    const size_t kstep = (size_t)(BK * 2);
    const size_t hstep = (size_t)HALF * K * 2;
    const unsigned ldsw = (unsigned)wid * 1024u;
    const int aoff = lds_byte(wr * 64 + fr, fq * 8), boff = lds_byte(wc * 32 + fr, fq * 8);
#define PG8_SA(b, h) (((b) * 2 + (h)) * HTB)
#define PG8_SB(b, h) ((4 + (b) * 2 + (h)) * HTB)
#define PG8_STAGE(bufoff, gbase, voff) do { _Pragma("unroll") for (int _i = 0; _i < 2; ++_i) \
        __builtin_amdgcn_global_load_lds((const unsigned*)((const char*)(gbase) + (voff)[_i]), (LAS unsigned*)(lds + (bufoff) + ldsw + _i * 8192), 16, 0, 0); } while (0)
#define PG8_LDA(dst, b, h) do { _Pragma("unroll") for (int m = 0; m < 4; ++m) _Pragma("unroll") for (int k = 0; k < 2; ++k) dst[m][k] = *(const LAS bf16x8*)(lds + PG8_SA(b, h) + aoff + m * 2048 + k * 1024); } while (0)
#define PG8_LDB(dst, b, h) do { _Pragma("unroll") for (int n = 0; n < 2; ++n) _Pragma("unroll") for (int k = 0; k < 2; ++k) dst[n][k] = *(const LAS bf16x8*)(lds + PG8_SB(b, h) + boff + n * 2048 + k * 1024); } while (0)
#define PG8_MMA(ai, bj, At, Bt) do { __builtin_amdgcn_s_setprio(1); _Pragma("unroll") for (int m = 0; m < 4; ++m) _Pragma("unroll") for (int n = 0; n < 2; ++n) _Pragma("unroll") for (int k = 0; k < 2; ++k) \
        acc[ai][bj][m][n] = __builtin_amdgcn_mfma_f32_16x16x32_bf16(Bt[n][k], At[m][k], acc[ai][bj][m][n], 0, 0, 0); __builtin_amdgcn_s_setprio(0); } while (0)
#define PG8_WAIT_V(n) asm volatile("s_waitcnt vmcnt(" #n ")" ::: "memory")
#define PG8_WAIT_L(n) asm volatile("s_waitcnt lgkmcnt(" #n ")" ::: "memory")
#define PG8_BAR __builtin_amdgcn_s_barrier()
#define PG8_SCHED __builtin_amdgcn_sched_barrier(0)
    Unit cur, nxt; int ui = 0;
    if (!S.next(0, cur)) return;
    f32x4 acc[2][2][4][2];
#pragma unroll
    for (int a = 0; a < 2; ++a)
#pragma unroll
        for (int b = 0; b < 2; ++b)
#pragma unroll
            for (int m = 0; m < 4; ++m)
#pragma unroll
                for (int n = 0; n < 2; ++n) acc[a][b][m][n] = (f32x4){0.f, 0.f, 0.f, 0.f};
    bf16x8 At[4][2], B0[2][2], B1[2][2];
    const char* cA = cur.A; const char* cB = cur.B;
    PG8_STAGE(PG8_SB(0, 0), cB, voffB); PG8_STAGE(PG8_SB(0, 1), cB + hstep, voffB); PG8_STAGE(PG8_SA(0, 0), cA, voffA); PG8_STAGE(PG8_SA(0, 1), cA + hstep, voffA);
    if (wr == 1) PG8_BAR;
    PG8_WAIT_V(2); PG8_BAR;
    PG8_STAGE(PG8_SB(1, 0), cB + kstep, voffB); PG8_STAGE(PG8_SA(1, 0), cA + kstep, voffA); PG8_STAGE(PG8_SB(1, 1), cB + hstep + kstep, voffB);
    PG8_WAIT_V(6); PG8_BAR;
    for (;;) {
        const bool has_next = S.next(ui + 1, nxt);
        const char* nA = has_next ? nxt.A : cA; const char* nB = has_next ? nxt.B : cB;
        for (int t = 0; t < nt; t += 2) {
            const bool last = (t == nt - 2);
            const char* a1 = cA + (size_t)(t + 1) * kstep;
            const char* a2 = last ? nA : cA + (size_t)(t + 2) * kstep; const char* b2 = last ? nB : cB + (size_t)(t + 2) * kstep;
            const char* a3 = a2 + kstep; const char* b3 = b2 + kstep;
            PG8_LDB(B0, 0, 0); PG8_LDB(B1, 0, 1); PG8_SCHED; PG8_LDA(At, 0, 0); PG8_STAGE(PG8_SA(1, 1), a1 + hstep, voffA);
            PG8_WAIT_V(8); PG8_WAIT_L(0); PG8_BAR; PG8_MMA(0, 0, At, B0); PG8_MMA(0, 1, At, B1); PG8_BAR; PG8_SCHED;
            PG8_LDA(At, 0, 1); PG8_STAGE(PG8_SB(0, 0), b2, voffB); PG8_STAGE(PG8_SB(0, 1), b2 + hstep, voffB); PG8_STAGE(PG8_SA(0, 0), a2, voffA);
            PG8_WAIT_V(8); PG8_WAIT_L(0); PG8_BAR; PG8_MMA(1, 0, At, B0); PG8_MMA(1, 1, At, B1); PG8_BAR; PG8_SCHED;
            PG8_LDB(B0, 1, 0); PG8_LDB(B1, 1, 1); PG8_SCHED; PG8_LDA(At, 1, 0); PG8_STAGE(PG8_SA(0, 1), a2 + hstep, voffA);
            PG8_WAIT_V(8); PG8_WAIT_L(0); PG8_BAR; PG8_MMA(0, 0, At, B0); PG8_MMA(0, 1, At, B1); PG8_BAR; PG8_SCHED;
            PG8_LDA(At, 1, 1); PG8_STAGE(PG8_SB(1, 0), b3, voffB); PG8_STAGE(PG8_SB(1, 1), b3 + hstep, voffB); PG8_STAGE(PG8_SA(1, 0), a3, voffA);
            PG8_WAIT_V(8); PG8_WAIT_L(0); PG8_BAR; PG8_MMA(1, 0, At, B0); PG8_MMA(1, 1, At, B1); PG8_BAR; PG8_SCHED;
        }
        if (wr == 0) PG8_BAR;
        epilogue(acc, cur, wr, wc, fr, fq);
        if (!has_next) break;
#pragma unroll
        for (int a = 0; a < 2; ++a)
#pragma unroll
            for (int b = 0; b < 2; ++b)
#pragma unroll
                for (int m = 0; m < 4; ++m)
#pragma unroll
                    for (int n = 0; n < 2; ++n) acc[a][b][m][n] = (f32x4){0.f, 0.f, 0.f, 0.f};
        cur = nxt; cA = nA; cB = nB; ++ui;
        if (wr == 1) PG8_BAR;
    }
    PG8_WAIT_V(0);
    PG8_BAR;
#undef PG8_SA
#undef PG8_SB
#undef PG8_STAGE
#undef PG8_LDA
#undef PG8_LDB
#undef PG8_MMA
#undef PG8_WAIT_V
#undef PG8_WAIT_L
#undef PG8_BAR
#undef PG8_SCHED
}
}

struct Args {
    const float* in[18]; float* out; unsigned char* ws;
    float lam_init[2]; int ph_lo, ph_hi;
};

struct SchedFold {
    unsigned char* ws; int G, c;
    __device__ __forceinline__ bool next(int i, pg8::Unit& u) const {
        const int L = i * G + c; if (L >= 64) return false;
        const int l = L >> 5, g = (L >> 3) & 3, pm = (L >> 2) & 1, pn = L & 3;
        u.A = (const char*)(ws + WS_WGT) + ((size_t)((l * 4 + g) * 512 + pm * 256) * 512) * 2;
        u.B = (const char*)(ws + WS_WU) + ((size_t)((l * 4 + g) * 1024 + pn * 256) * 512) * 2;
        u.O = (bf16_t*)(ws + WS_WA) + (size_t)l * 4096 * 1024 + (size_t)(g * 512 + pm * 256) * 1024 + pn * 256;
        u.ldc = 1024; u.scale = 1.f; u.mode = 0; u.aux = nullptr; u.bjs = 128; return true;
    }
};
struct SchedA1 {
    unsigned char* ws; bf16_t* Gbuf; const float* ch_scale; int l, G, c;
    __device__ __forceinline__ bool next(int i, pg8::Unit& u) const {
        const int L = (i >> 1) * G + c; if (L >= 1024) return false;
        const int pm = (L >> 5) * 4 + (L & 3), jn = (L >> 2) & 7, kind = i & 1;
        const bf16_t* H5 = (const bf16_t*)(ws + WS_H5);
        const bf16_t* WA = (const bf16_t*)(ws + WS_WA) + (size_t)l * 4096 * 1024;
        const int slot = kind ? 1 + (jn >> 1) : 0;
        u.A = (const char*)(H5 + (size_t)slot * M * 1024 + (size_t)pm * 256 * 1024);
        u.B = (const char*)(WA + (size_t)((kind ? 0 : 2048) + jn * 256) * 1024);
        u.O = Gbuf + (size_t)pm * 256 * 2048 + jn * 256; u.ldc = 2048; u.scale = 1.f; u.mode = kind ? 2 : 1; u.aux = ch_scale + jn * 256; u.bjs = 128; return true;
    }
};
struct SchedN1024 {
    const bf16_t* A; const bf16_t* Bt; bf16_t* O; int K, G, c;
    __device__ __forceinline__ bool next(int i, pg8::Unit& u) const {
        const int L = i * G + c; if (L >= 512) return false;
        const int pm = (L >> 5) * 8 + (L & 7), pn = (L >> 3) & 3;
        u.A = (const char*)(A + (size_t)pm * 256 * K); u.B = (const char*)(Bt + (size_t)pn * 256 * K);
        u.O = O + (size_t)pm * 256 * 1024 + pn * 256; u.ldc = 1024; u.scale = 1.f; u.mode = 0; u.aux = nullptr; u.bjs = 128; return true;
    }
};
struct SchedB1 {
    unsigned char* ws; const bf16_t* Wbin; bf16_t* Zbuf; int with_kv, G, c;
    __device__ __forceinline__ bool next(int i, pg8::Unit& u) const {
        int L = i * G + c; const int tot = with_kv ? 2048 : 1024; if (L >= tot) return false;
        const bf16_t* H5 = (const bf16_t*)(ws + WS_H5);
        const bf16_t* h = H5; const bf16_t* hk = H5 + (size_t)M * 1024;
        bf16_t* Kb = (bf16_t*)(ws + WS_H5 + 2 * SLOT); bf16_t* Vt = (bf16_t*)(ws + WS_H5 + 3 * SLOT); bf16_t* Qb = (bf16_t*)(ws + WS_H5 + 4 * SLOT);
        const bf16_t* Wkv = (const bf16_t*)(ws + WS_WKV);
        u.mode = 0; u.aux = nullptr; u.scale = 1.f; u.ldc = 1024; u.bjs = 128;
        if (L < 1024) {
            const int pm = (L >> 5) * 4 + (L & 3), pn = (L >> 2) & 7;
            u.A = (const char*)(h + (size_t)pm * 256 * 1024); u.B = (const char*)(Wbin + (size_t)pn * 256 * 1024);
            if (pn < 4) { u.O = Qb + (size_t)pm * 256 * 1024 + pn * 256; u.scale = C2; } else { u.O = Zbuf + (size_t)pm * 256 * 1024 + (pn - 4) * 256; }
        } else if (L < 1536) {
            L -= 1024; const int pm = (L >> 5) * 8 + (L & 7), pn = (L >> 3) & 3;
            u.A = (const char*)(hk + (size_t)pm * 256 * 1024); u.B = (const char*)(Wkv + (size_t)pn * 256 * 1024);
            u.O = Kb + ((size_t)((pm >> 3) * 8 + 2 * pn) * 2048 + (pm & 7) * 256) * 128; u.ldc = 128; u.bjs = 2048 * 128;
        } else {
            L -= 1536; const int pn = (L >> 5) * 8 + (L & 7), pm = (L >> 3) & 3;
            u.A = (const char*)(Wkv + (size_t)(1024 + pm * 256) * 1024); u.B = (const char*)(hk + (size_t)pn * 256 * 1024);
            u.O = Vt + ((size_t)((pn >> 3) * 8 + 2 * pm) * 128) * 2048 + (pn & 7) * 256; u.ldc = 2048;
        }
        return true;
    }
};

__device__ __forceinline__ void transpose_item(const float* W, int ldw, int K, bf16_t* WT, LAS float* scr, int kb, int nb, int lane) {
    const int k0 = 64 * kb, n0 = 32 * nb;
    float tv[32];
#pragma unroll
    for (int i = 0; i < 32; ++i) { const int kk = 2 * i + (lane >> 5); tv[i] = W[(size_t)(k0 + kk) * ldw + n0 + (lane & 31)]; }
#pragma unroll
    for (int i = 0; i < 32; ++i) { const int kk = 2 * i + (lane >> 5); scr[kk * 33 + (lane & 31)] = tv[i]; }
    asm volatile("s_waitcnt lgkmcnt(0)" ::: "memory");
    const int c = lane & 7;
#pragma unroll
    for (int j = 0; j < 4; ++j) { const int n = (lane >> 3) + 8 * j; const LAS float* s = scr + (8 * c) * 33 + n;
        u32x4 o; o.x = cvt_pk_bf16(s[0 * 33], s[1 * 33]); o.y = cvt_pk_bf16(s[2 * 33], s[3 * 33]); o.z = cvt_pk_bf16(s[4 * 33], s[5 * 33]); o.w = cvt_pk_bf16(s[6 * 33], s[7 * 33]);
        *(u32x4*)(WT + (size_t)(n0 + n) * K + k0 + 8 * c) = o; }
    asm volatile("s_waitcnt lgkmcnt(0)" ::: "memory");
}

__device__ __forceinline__ void phase_p0a(const Args& a, LAS unsigned char* lds, int G, int vcu, const bool do_gemv, const int it_lo, const int it_hi) {
    const int tid = threadIdx.x, lane = tid & 63, wave = __builtin_amdgcn_readfirstlane(tid >> 6);
    unsigned char* ws = a.ws;
    LAS float* cl = (LAS float*)lds;
    LAS float* red = (LAS float*)(lds + 65536);
    bool cl_ready = false;
    for (int T = vcu; T < (do_gemv ? 224 : 0); T += G) {
        if (!cl_ready) {
            for (int e = tid; e < 16 * 1024; e += 512) cl[e] = silu_f(a.in[1][e]);
            cl_ready = true;
        }
        __syncthreads();
        const int n0 = T * 64; const float* W; const float* bias; float* out; int ldw;
        if (n0 < 12288) { const int l = n0 / 3072, nn = n0 % 3072; W = a.in[2] + (size_t)l * 1024 * 3072 + nn; ldw = 3072; bias = a.in[3] + l * 3072 + nn; out = (float*)(ws + WS_ADA) + (size_t)l * 16 * 3072 + nn; }
        else { const int nn = n0 - 12288; W = a.in[11] + nn; ldw = 2048; bias = a.in[12] + nn; out = (float*)(ws + WS_KVADA) + nn; }
        float acc[16];
#pragma unroll
        for (int b = 0; b < 16; ++b) acc[b] = 0.f;
        const int kbeg = wave * 128;
#pragma unroll 2
        for (int k = kbeg; k < kbeg + 128; k += 4) {
            const float w0 = W[(size_t)(k + 0) * ldw + lane], w1 = W[(size_t)(k + 1) * ldw + lane], w2 = W[(size_t)(k + 2) * ldw + lane], w3 = W[(size_t)(k + 3) * ldw + lane];
#pragma unroll
            for (int b = 0; b < 16; ++b) { const f32x4 cv = *(const LAS f32x4*)(cl + b * 1024 + k); acc[b] += (cv.x * w0 + cv.y * w1) + (cv.z * w2 + cv.w * w3); }
        }
#pragma unroll
        for (int b = 0; b < 16; ++b) red[(wave * 16 + b) * 64 + lane] = acc[b];
        __syncthreads();
#pragma unroll
        for (int bb = 0; bb < 2; ++bb) { const int b = wave + 8 * bb; float s = bias[lane];
#pragma unroll
            for (int w = 0; w < 8; ++w) s += red[(w * 16 + b) * 64 + lane];
            out[(size_t)b * ldw + lane] = s; }
    }
    __syncthreads();
    LAS float* scr = (LAS float*)(lds + wave * 8448);
    const int gw = vcu * 8 + wave, NGW = G * 8;
    bf16_t* WA = (bf16_t*)(ws + WS_WA); bf16_t* WOUT = (bf16_t*)(ws + WS_WOUT); bf16_t* WKV = (bf16_t*)(ws + WS_WKV);
    bf16_t* WBIN = (bf16_t*)(ws + WS_WBIN); bf16_t* WBOUT = (bf16_t*)(ws + WS_WBOUT); bf16_t* WGT = (bf16_t*)(ws + WS_WGT); bf16_t* WU = (bf16_t*)(ws + WS_WU);
    for (int it = it_lo + gw; it < it_hi; it += NGW) {
        int r = it;
        if (r < 2048) { const int l = r >> 10; r &= 1023;
            transpose_item(a.in[6] + (size_t)l * 1024 * 4096 + 2048, 4096, 1024, WA + (size_t)l * 4096 * 1024 + (size_t)2048 * 1024, scr, r >> 6, r & 63, lane); continue; } r -= 2048;
        if (r < 2048) { const int l = r >> 10; r &= 1023;
            transpose_item(a.in[9] + (size_t)l * 2048 * 1024, 1024, 2048, WOUT + (size_t)l * 1024 * 2048, scr, r >> 5, r & 31, lane); continue; } r -= 2048;
        if (r < 1024) { transpose_item(a.in[13], 2048, 1024, WKV, scr, r >> 6, r & 63, lane); continue; } r -= 1024;
        if (r < 2048) { const int j = r >> 10; r &= 1023;
            transpose_item(a.in[14] + (size_t)j * 1024 * 2048, 2048, 1024, WBIN + (size_t)j * 2048 * 1024, scr, r >> 6, r & 63, lane); continue; } r -= 2048;
        if (r < 1024) { const int j = r >> 9; r &= 511;
            transpose_item(a.in[17] + (size_t)j * 1024 * 1024, 1024, 1024, WBOUT + (size_t)j * 1024 * 1024, scr, r >> 5, r & 31, lane); continue; } r -= 1024;
        if (r < 1024) { const int lg = r >> 7; r &= 127;
            transpose_item(a.in[7] + (size_t)lg * 512 * 512, 512, 512, WGT + (size_t)lg * 512 * 512, scr, r >> 4, r & 15, lane); continue; } r -= 1024;
        {
            const int l = r >> 10, k = r & 1023; const float* src = a.in[6] + ((size_t)l * 1024 + k) * 4096;
#pragma unroll
            for (int q = 0; q < 4; ++q) { const int col = q * 512 + lane * 8; const f32x4 v0 = *(const f32x4*)(src + col), v1 = *(const f32x4*)(src + col + 4);
                u32x4 o; o.x = cvt_pk_bf16(v0.x, v0.y); o.y = cvt_pk_bf16(v0.z, v0.w); o.z = cvt_pk_bf16(v1.x, v1.y); o.w = cvt_pk_bf16(v1.z, v1.w);
                *(u32x4*)(WU + ((size_t)(l * 4 + q) * 1024 + k) * 512 + lane * 8) = o; }
        }
    }
}

struct RowP { f32x4 gp[4], sc[4], sh[4]; };
__device__ __forceinline__ void load_rowp(RowP& P, const float* ada_prev  , const float* npost, const float* ada_next, const float* npre, int lane) {
#pragma unroll
    for (int j = 0; j < 4; ++j) {
        const int col = 4 * lane + 256 * j;
        if (ada_prev) P.gp[j] = *(const f32x4*)(ada_prev + 2048 + col) * *(const f32x4*)(npost + col); else P.gp[j] = (f32x4){0.f, 0.f, 0.f, 0.f};
        if (ada_next) { P.sc[j] = *(const f32x4*)(npre + col) * (*(const f32x4*)(ada_next + 1024 + col) + 1.0f); P.sh[j] = *(const f32x4*)(ada_next + col); }
        else { P.sc[j] = (f32x4){0.f, 0.f, 0.f, 0.f}; P.sh[j] = P.sc[j]; }
    }
}
struct RowIn { f32x4 x[4]; u32x2 y[4]; };
template <bool XBF = false>
__device__ __forceinline__ void row_load(RowIn& R, const void* xrow_, const bf16_t* yrow, int lane) {
    if (XBF) { const bf16_t* xrow = (const bf16_t*)xrow_;
#pragma unroll
        for (int j = 0; j < 4; ++j) { const u32x2 w = *(const u32x2*)(xrow + 4 * lane + 256 * j); R.x[j] = (f32x4){bf_lo(w.x), bf_hi(w.x), bf_lo(w.y), bf_hi(w.y)}; }
    } else { const float* xrow = (const float*)xrow_;
#pragma unroll
        for (int j = 0; j < 4; ++j) R.x[j] = *(const f32x4*)(xrow + 4 * lane + 256 * j); }
    if (yrow) {
#pragma unroll
        for (int j = 0; j < 4; ++j) R.y[j] = *(const u32x2*)(yrow + 4 * lane + 256 * j);
    }
}
__device__ __forceinline__ float row_compute(f32x4 (&xv)[4], const RowIn& R, bool has_y, const RowP& P) {
#pragma unroll
    for (int j = 0; j < 4; ++j) xv[j] = R.x[j];
    if (has_y) {
        f32x4 yv[4]; float s = 0.f;
#pragma unroll
        for (int j = 0; j < 4; ++j) { const u32x2 w = R.y[j]; yv[j] = (f32x4){bf_lo(w.x), bf_hi(w.x), bf_lo(w.y), bf_hi(w.y)};
            s += (yv[j].x * yv[j].x + yv[j].y * yv[j].y) + (yv[j].z * yv[j].z + yv[j].w * yv[j].w); }
        const float ry = __builtin_amdgcn_rsqf(wave_sum(s) * (1.f / 1024.f) + EPS);
#pragma unroll
        for (int j = 0; j < 4; ++j) xv[j] = xv[j] + P.gp[j] * (yv[j] * ry);
    }
    float s2 = 0.f;
#pragma unroll
    for (int j = 0; j < 4; ++j) s2 += (xv[j].x * xv[j].x + xv[j].y * xv[j].y) + (xv[j].z * xv[j].z + xv[j].w * xv[j].w);
    return __builtin_amdgcn_rsqf(wave_sum(s2) * (1.f / 1024.f) + EPS);
}
__device__ __forceinline__ float row_update(f32x4 (&xv)[4], const float* xrow, const bf16_t* yrow, const RowP& P, int lane) {
    RowIn R; row_load(R, xrow, yrow, lane); return row_compute(xv, R, yrow != nullptr, P);
}

template <bool XOB> __device__ __forceinline__ void phase_e_pool(const float* xold, const bf16_t* y, void* xnew_, const float* ada_prev_all  , const float* npost,
                                             const float* ada_next_all, const float* npre, bf16_t* H5, LAS unsigned char* lds, int G, int vcu) {
    const int tid = threadIdx.x, lane = tid & 63, wave = __builtin_amdgcn_readfirstlane(tid >> 6);
    LAS unsigned char* hbuf = lds;
    for (int T = vcu; T < M / 128; T += G) {
        const int m0 = T * 128, b = m0 / SEQ, t0 = m0 % SEQ;
        RowP P; load_rowp(P, ada_prev_all ? ada_prev_all + b * 3072 : nullptr, npost, ada_next_all + b * 3072, npre, lane);
        for (int c = 0; c < 9; ++c) {
            u32x2 xs[2][4];
#pragma unroll
            for (int rr = 0; rr < 2; ++rr) {
                const int r = wave * 2 + rr, t = t0 - 16 + 16 * c + r, m = m0 - 16 + 16 * c + r, slot = (16 * c + r) & 31;
                LAS unsigned char* hrow = hbuf + slot * 2048;
                if (t < 0) {
#pragma unroll
                    for (int j = 0; j < 4; ++j) { *(LAS u32x2*)(hrow + (4 * lane + 256 * j) * 2) = (u32x2){0u, 0u}; xs[rr][j] = (u32x2){0u, 0u}; }
                } else {
                    f32x4 xv[4]; const float rx = row_update(xv, xold + (size_t)m * D, y ? y + (size_t)m * D : nullptr, P, lane);
#pragma unroll
                    for (int j = 0; j < 4; ++j) { xs[rr][j] = (u32x2){cvt_pk_bf16(xv[j].x, xv[j].y), cvt_pk_bf16(xv[j].z, xv[j].w)};
                        const f32x4 h = xv[j] * rx * P.sc[j] + P.sh[j];
                        *(LAS u32x2*)(hrow + (4 * lane + 256 * j) * 2) = (u32x2){cvt_pk_bf16(h.x, h.y), cvt_pk_bf16(h.z, h.w)}; }
                }
            }
            if (XOB && y && c >= 1) { bf16_t* xnew = (bf16_t*)xnew_;
#pragma unroll
                for (int rr = 0; rr < 2; ++rr) { const size_t m = (size_t)m0 - 16 + 16 * c + wave * 2 + rr;
#pragma unroll
                    for (int j = 0; j < 4; ++j) *(u32x2*)(xnew + m * D + 4 * lane + 256 * j) = xs[rr][j]; }
            }
            __syncthreads();
            if (c >= 1) {
                const int half = tid >> 8, c4 = tid & 255;
                f32x4 hist[23];
#pragma unroll
                for (int i = 0; i < 23; ++i) { const int slot = (16 * c + 8 * half - 15 + i) & 31; const u32x2 w = *(const LAS u32x2*)(hbuf + slot * 2048 + c4 * 8);
                    hist[i] = (f32x4){bf_lo(w.x), bf_hi(w.x), bf_lo(w.y), bf_hi(w.y)}; }
#pragma unroll
                for (int j = 0; j < 8; ++j) {
                    const int rloc = 16 * (c - 1) + 8 * half + j, t = t0 + rloc; const size_t m = (size_t)m0 + rloc;
                    const f32x4 v0 = hist[j + 15];
                    f32x4 s2 = v0 + hist[j + 14];
                    f32x4 s4 = s2 + (hist[j + 13] + hist[j + 12]);
                    f32x4 s8 = s4 + ((hist[j + 11] + hist[j + 10]) + (hist[j + 9] + hist[j + 8]));
                    f32x4 s16 = s8 + (((hist[j + 7] + hist[j + 6]) + (hist[j + 5] + hist[j + 4])) + ((hist[j + 3] + hist[j + 2]) + (hist[j + 1] + hist[j + 0])));
                    const float i2 = 1.f / (float)min(t + 1, 2), i4 = 1.f / (float)min(t + 1, 4), i8 = 1.f / (float)min(t + 1, 8), i16 = 1.f / (float)min(t + 1, 16);
                    const f32x4 o2 = s2 * i2 - v0, o4 = s4 * i4 - v0, o8 = s8 * i8 - v0, o16 = s16 * i16 - v0;
                    bf16_t* dst = H5 + m * 1024 + c4 * 4;
                    *(u32x2*)(dst) = (u32x2){cvt_pk_bf16(v0.x, v0.y), cvt_pk_bf16(v0.z, v0.w)};
                    *(u32x2*)(dst + (size_t)1 * M * 1024) = (u32x2){cvt_pk_bf16(o2.x, o2.y), cvt_pk_bf16(o2.z, o2.w)};
                    *(u32x2*)(dst + (size_t)2 * M * 1024) = (u32x2){cvt_pk_bf16(o4.x, o4.y), cvt_pk_bf16(o4.z, o4.w)};
                    *(u32x2*)(dst + (size_t)3 * M * 1024) = (u32x2){cvt_pk_bf16(o8.x, o8.y), cvt_pk_bf16(o8.z, o8.w)};
                    *(u32x2*)(dst + (size_t)4 * M * 1024) = (u32x2){cvt_pk_bf16(o16.x, o16.y), cvt_pk_bf16(o16.z, o16.w)};
                }
            }
            __syncthreads();
        }
    }
}

template <bool XIB, bool XOB> __device__ __forceinline__ void phase_e_rows(const void* xold_, const bf16_t* y, void* xnew_, const float* ada_prev_all, const float* npost,
                                             const float* ada_next_all, const float* npre, bf16_t* hout,
                                             const float* kvada_all  , const float* kvnorm, bf16_t* hkout, int G, int vcu) {
    const int tid = threadIdx.x, lane = tid & 63, wave = __builtin_amdgcn_readfirstlane(tid >> 6);
    for (int grp = vcu * 8 + wave; grp < M / 16; grp += G * 8) {
        const int m0 = grp * 16, b = m0 / SEQ;
        RowP P; load_rowp(P, ada_prev_all + b * 3072, npost, ada_next_all ? ada_next_all + b * 3072 : nullptr, npre, lane);
        f32x4 ksc[4], ksh[4];
        if (kvada_all) {
#pragma unroll
            for (int j = 0; j < 4; ++j) { const int col = 4 * lane + 256 * j; ksc[j] = *(const f32x4*)(kvnorm + col) * (*(const f32x4*)(kvada_all + b * 2048 + 1024 + col) + 1.0f); ksh[j] = *(const f32x4*)(kvada_all + b * 2048 + col); }
        }
        const size_t xes = XIB ? 2 : 4;
        RowIn Rn; row_load<XIB>(Rn, (const char*)xold_ + (size_t)m0 * D * xes, y + (size_t)m0 * D, lane);
        for (int r = 0; r < 16; ++r) {
            const size_t m = (size_t)m0 + r;
            const RowIn Rc = Rn;
            if (r + 1 < 16) row_load<XIB>(Rn, (const char*)xold_ + (m + 1) * D * xes, y + (m + 1) * D, lane);
            f32x4 xv[4]; const float rx = row_compute(xv, Rc, true, P);
            if (XOB) { bf16_t* xnew = (bf16_t*)xnew_;
#pragma unroll
                for (int j = 0; j < 4; ++j) *(u32x2*)(xnew + m * D + 4 * lane + 256 * j) = (u32x2){cvt_pk_bf16(xv[j].x, xv[j].y), cvt_pk_bf16(xv[j].z, xv[j].w)};
            } else { float* xnew = (float*)xnew_;
#pragma unroll
                for (int j = 0; j < 4; ++j) *(f32x4*)(xnew + m * D + 4 * lane + 256 * j) = xv[j]; }
            if (ada_next_all) {
#pragma unroll
                for (int j = 0; j < 4; ++j) { const f32x4 h = xv[j] * rx * P.sc[j] + P.sh[j];
                    *(u32x2*)(hout + m * D + 4 * lane + 256 * j) = (u32x2){cvt_pk_bf16(h.x, h.y), cvt_pk_bf16(h.z, h.w)}; }
            }
            if (kvada_all) {
#pragma unroll
                for (int j = 0; j < 4; ++j) { const f32x4 h = xv[j] * rx * ksc[j] + ksh[j];
                    *(u32x2*)(hkout + m * D + 4 * lane + 256 * j) = (u32x2){cvt_pk_bf16(h.x, h.y), cvt_pk_bf16(h.z, h.w)}; }
            }
        }
    }
}

namespace att {
constexpr int KSTR = 144, VSTR = 144, K_BYTES = 64 * KSTR, V_OFF = 2 * K_BYTES, STAGE = V_OFF + 128 * VSTR;
constexpr int X_OFF = 0, Y_OFF = 65536, YSTR = 272;
__device__ __forceinline__ float max3f(float a, float b, float c) { return __builtin_fmaxf(__builtin_fmaxf(a, b), c); }
template <int VAR> __device__ __forceinline__ void attn_unit(int b, int hd, int qb, const bf16_t* QO, bf16_t* Ob, const bf16_t* Kb, const bf16_t* Vt, const bf16_t* Zb, const float* subln, float lam, float one_m_li, LAS unsigned char* lds) {
    const int tid = threadIdx.x, lane = tid & 63, l32 = lane & 31, hi = lane >> 5, wave = __builtin_amdgcn_readfirstlane(tid >> 6);
    const int mp = wave >> 2, qw = wave & 3;
    const size_t rowbase = (size_t)b * SEQ; const int q0 = qb * 128;
    const int NT = 2 * qb + 2, my_last = 2 * qb + (qw >> 1);
    const int srow = tid >> 3, sp = tid & 7, vrow = tid >> 2, vq = tid & 3;
    const bf16_t* kg = Kb + ((size_t)(b * 8 + hd) * 2048 + srow) * 128 + sp * 8;
    const bf16_t* vg = Vt + ((size_t)(b * 8 + hd) * 128 + vrow) * 2048 + vq * 16;
    const int kl = srow * KSTR + sp * 16, vl = V_OFF + vrow * VSTR + vq * 32;
    bf16x8 qf[4];
    { const bf16_t* qp = QO + (rowbase + q0 + 32 * qw + l32) * 1024 + hd * 128 + mp * 64 + hi * 8;
#pragma unroll
      for (int kk = 0; kk < 4; ++kk) qf[kk] = *(const bf16x8*)(qp + kk * 16); }
    u32x4 rk0, rk1, rv0, rv1;
#define STAGE_LOAD(t) do { const size_t ko = (size_t)(t) * 64 * 128, vo = (size_t)(t) * 64; \
        rk0 = *(const u32x4*)(kg + ko); rk1 = *(const u32x4*)(kg + ko + 64); rv0 = *(const u32x4*)(vg + vo); rv1 = *(const u32x4*)(vg + vo + 8); } while (0)
#define STAGE_STORE(stoff) do { LAS unsigned char* st_ = lds + (stoff); \
        *(LAS u32x4*)(st_ + kl) = rk0; *(LAS u32x4*)(st_ + K_BYTES + kl) = rk1; \
        *(LAS u32x4*)(st_ + vl) = (u32x4){rv0.x, rv0.y, rv1.x, rv1.y}; *(LAS u32x4*)(st_ + vl + 16) = (u32x4){rv0.z, rv0.w, rv1.z, rv1.w}; } while (0)
    STAGE_LOAD(0);
    STAGE_STORE(0);
    __syncthreads();
    f32x16 o[4];
#pragma unroll
    for (int i = 0; i < 4; ++i) o[i] = (f32x16){0.f, 0.f, 0.f, 0.f, 0.f, 0.f, 0.f, 0.f, 0.f, 0.f, 0.f, 0.f, 0.f, 0.f, 0.f, 0.f};
    f32x16 negm = (f32x16){0.f, 0.f, 0.f, 0.f, 0.f, 0.f, 0.f, 0.f, 0.f, 0.f, 0.f, 0.f, 0.f, 0.f, 0.f, 0.f};
    float mhat = 0.f, lsum = 0.f;
    u32x4 pw[4];
    pw[0] = pw[1] = pw[2] = pw[3] = (u32x4){0u, 0u, 0u, 0u};
    const int koff = mp * K_BYTES + l32 * KSTR + hi * 16, voff = V_OFF + l32 * VSTR + hi * 16;
#define LOADV(stoff, D0, D1) _Pragma("unroll") for (int dvb = D0; dvb < D1; ++dvb) _Pragma("unroll") for (int sj = 0; sj < 4; ++sj) \
        vf[(dvb & 1) * 4 + sj] = *(const LAS bf16x8*)(lds + (stoff) + voff + dvb * 32 * VSTR + sj * 32);
#define PVMMA(D0, D1) _Pragma("unroll") for (int dvb = D0; dvb < D1; ++dvb) _Pragma("unroll") for (int sj = 0; sj < 4; ++sj) \
        o[dvb] = __builtin_amdgcn_mfma_f32_32x32x16_bf16(vf[(dvb & 1) * 4 + sj], __builtin_bit_cast(bf16x8, pw[sj]), o[dvb], 0, 0, 0);
#define PV_ALL(stoff) do { { bf16x8 vf[8]; LOADV(stoff, 0, 2) PVMMA(0, 2) } { bf16x8 vf[8]; LOADV(stoff, 2, 4) PVMMA(2, 4) } } while (0)
#define EXPS(sX, J0) do { \
        _Pragma("unroll") for (int r = 0; r < 16; ++r) { sX[r] = __builtin_amdgcn_exp2f(sX[r]); ps += sX[r]; } \
        _Pragma("unroll") for (int j = 0; j < 2; ++j) \
            pn[J0 + j] = (u32x4){cvt_pk_bf16(sX[8 * j], sX[8 * j + 1]), cvt_pk_bf16(sX[8 * j + 2], sX[8 * j + 3]), cvt_pk_bf16(sX[8 * j + 4], sX[8 * j + 5]), cvt_pk_bf16(sX[8 * j + 6], sX[8 * j + 7])}; \
    } while (0)
#define BAR_LDS() asm volatile("s_waitcnt lgkmcnt(0)\n\ts_barrier" ::: "memory")
    int so_prev = 0, so_cur = 0, so_next = STAGE;
    for (int kt = 0; kt < NT; ++kt) {
        const bool more = (kt + 1 < NT);
        if (more && !(VAR & 1)) STAGE_LOAD(kt + 1);
        if (!(VAR & 2)) {
            {
                const bool act = (kt <= my_last);
                __builtin_amdgcn_s_setprio(2);
                bf16x8 kf[8];
#pragma unroll
                for (int kk = 0; kk < 4; ++kk) { kf[2 * kk] = *(const LAS bf16x8*)(lds + so_cur + koff + kk * 32); kf[2 * kk + 1] = *(const LAS bf16x8*)(lds + so_cur + koff + 32 * KSTR + kk * 32); }
                f32x16 s0 = __builtin_amdgcn_mfma_f32_32x32x16_bf16(kf[0], qf[0], negm, 0, 0, 0);
                f32x16 s1 = __builtin_amdgcn_mfma_f32_32x32x16_bf16(kf[1], qf[0], negm, 0, 0, 0);
#pragma unroll
                for (int kk = 1; kk < 4; ++kk) {
                    s0 = __builtin_amdgcn_mfma_f32_32x32x16_bf16(kf[2 * kk], qf[kk], s0, 0, 0, 0);
                    s1 = __builtin_amdgcn_mfma_f32_32x32x16_bf16(kf[2 * kk + 1], qf[kk], s1, 0, 0, 0);
                }
                float m0 = max3f(s0[0], s0[1], s0[2]), m1 = max3f(s0[8], s0[9], s0[10]), m2 = max3f(s1[0], s1[1], s1[2]), m3 = max3f(s1[8], s1[9], s1[10]);
                m0 = max3f(m0, s0[3], s0[4]); m1 = max3f(m1, s0[11], s0[12]); m2 = max3f(m2, s1[3], s1[4]); m3 = max3f(m3, s1[11], s1[12]);
                m0 = max3f(m0, s0[5], s0[6]); m1 = max3f(m1, s0[13], s0[14]); m2 = max3f(m2, s1[5], s1[6]); m3 = max3f(m3, s1[13], s1[14]);
                m0 = max3f(m0, s0[7], m1); m2 = max3f(m2, s1[7], m3);
                const float lm = max3f(m0, m2, fmaxf(s0[15], s1[15]));
                u32x4 pn[4]; float ps = 0.f, f = 1.0f;
                const bool rare = (kt == 0) || __any(act && lm > 8.0f);
                if (rare) {
                    const float mx = fmaxf(lm, __shfl_xor(lm, 32));
                    const float dl = (kt == 0) ? mx : fmaxf(mx, 0.f);
                    f = __builtin_amdgcn_exp2f(-dl); mhat += dl;
#pragma unroll
                    for (int r = 0; r < 16; ++r) { s0[r] -= dl; s1[r] -= dl; negm[r] = -mhat; }
                }
                __builtin_amdgcn_s_setprio(1);
#define PV_EXP_PATTERN() do { __builtin_amdgcn_sched_group_barrier(0x100, 2, 0); \
        _Pragma("unroll") for (int g_ = 0; g_ < 8; ++g_) { __builtin_amdgcn_sched_group_barrier(0x008, 1, 0); __builtin_amdgcn_sched_group_barrier(0x100, 1, 0); __builtin_amdgcn_sched_group_barrier(0x002, 5, 0); } } while (0)
                { bf16x8 vf[8]; LOADV(so_prev, 0, 2) PVMMA(0, 2) EXPS(s0, 0); asm volatile("" : "+v"(pn[0]), "+v"(pn[1]), "+v"(ps)); PV_EXP_PATTERN(); }
                __builtin_amdgcn_sched_barrier(0);
                { bf16x8 vf[8]; LOADV(so_prev, 2, 4) PVMMA(2, 4) EXPS(s1, 2); asm volatile("" : "+v"(pn[2]), "+v"(pn[3]), "+v"(ps)); PV_EXP_PATTERN(); }
                __builtin_amdgcn_sched_barrier(0);
#undef PV_EXP_PATTERN
                __builtin_amdgcn_s_setprio(0);
                if (rare && kt > 0) {
                    lsum *= f;
#pragma unroll
                    for (int i = 0; i < 4; ++i)
#pragma unroll
                        for (int r = 0; r < 16; ++r) o[i][r] *= f;
                }
                lsum += act ? ps : 0.f;
                const unsigned keep = act ? 0xffffffffu : 0u;
#pragma unroll
                for (int j = 0; j < 4; ++j) pw[j] = (u32x4){pn[j].x & keep, pn[j].y & keep, pn[j].z & keep, pn[j].w & keep};
            }
        }
        if (more && !(VAR & 1)) STAGE_STORE(so_next);
        BAR_LDS();
        so_prev = so_cur; so_cur = so_next; so_next = (so_next == 2 * STAGE) ? 0 : so_next + STAGE;
    }
    if (!(VAR & 2) && NT - 1 <= my_last) PV_ALL(so_prev);
#undef BAR_LDS
#undef EXPS
#undef PV_ALL
#undef STAGE_LOAD
#undef STAGE_STORE
#undef LOADV
#undef PVMMA
    const int fw = wave >> 1, fh = wave & 1, pc = lane & 15;
    u32x4 zpre[4];
#pragma unroll
    for (int i = 0; i < 4; ++i) { const int q = 16 * fh + 4 * i + (lane >> 4); zpre[i] = *(const u32x4*)(Zb + (rowbase + q0 + 32 * fw + q) * 1024 + hd * 128 + 8 * pc); }
    const f32x4 g0 = *(const f32x4*)(subln + 8 * pc), g1 = *(const f32x4*)(subln + 8 * pc + 4);
    __syncthreads();
    { const auto rr = __builtin_amdgcn_permlane32_swap(__float_as_uint(lsum), __float_as_uint(lsum), false, false); lsum = __uint_as_float(rr[0]) + __uint_as_float(rr[1]); }
    const float sc = (mp == 0 ? 1.0f : -lam) * __builtin_amdgcn_rcpf(lsum);
    LAS f32x4* xb = (LAS f32x4*)(lds + X_OFF) + qw * 1024 + lane;
    if (mp == 1) {
#pragma unroll
        for (int i = 0; i < 4; ++i)
#pragma unroll
            for (int rg = 0; rg < 4; ++rg) xb[(i * 4 + rg) * 64] = (f32x4){o[i][4 * rg] * sc, o[i][4 * rg + 1] * sc, o[i][4 * rg + 2] * sc, o[i][4 * rg + 3] * sc};
    }
    __syncthreads();
    if (mp == 0) {
        float ssq = 0.f;
#pragma unroll
        for (int i = 0; i < 4; ++i)
#pragma unroll
            for (int rg = 0; rg < 4; ++rg) { const f32x4 t = xb[(i * 4 + rg) * 64];
#pragma unroll
                for (int e = 0; e < 4; ++e) { const float v = o[i][4 * rg + e] * sc + t[e]; o[i][4 * rg + e] = v; ssq += v * v; } }
        { const auto rr = __builtin_amdgcn_permlane32_swap(__float_as_uint(ssq), __float_as_uint(ssq), false, false); ssq = __uint_as_float(rr[0]) + __uint_as_float(rr[1]); }
        const float rs = __builtin_amdgcn_rsqf(ssq * (1.f / 128.f) + SUBLN_EPS) * one_m_li;
        LAS unsigned char* yb = lds + Y_OFF + qw * (32 * YSTR);
#pragma unroll
        for (int i = 0; i < 4; ++i)
#pragma unroll
            for (int rg = 0; rg < 4; ++rg)
                *(LAS u32x2*)(yb + l32 * YSTR + (32 * i + 8 * rg + 4 * hi) * 2) = (u32x2){cvt_pk_bf16(o[i][4 * rg] * rs, o[i][4 * rg + 1] * rs), cvt_pk_bf16(o[i][4 * rg + 2] * rs, o[i][4 * rg + 3] * rs)};
    }
    __syncthreads();
    {
        const LAS unsigned char* yb = lds + Y_OFF + fw * (32 * YSTR);
#pragma unroll
        for (int i = 0; i < 4; ++i) {
            const int q = 16 * fh + 4 * i + (lane >> 4);
            const u32x4 yv = *(const LAS u32x4*)(yb + q * YSTR + pc * 16);
            const size_t off = (rowbase + q0 + 32 * fw + q) * 1024 + hd * 128 + 8 * pc;
            const u32x4 zv = zpre[i];
            u32x4 w;
            w.x = cvt_pk_bf16(bf_lo(yv.x) * g0.x * silu_f(bf_lo(zv.x)), bf_hi(yv.x) * g0.y * silu_f(bf_hi(zv.x)));
            w.y = cvt_pk_bf16(bf_lo(yv.y) * g0.z * silu_f(bf_lo(zv.y)), bf_hi(yv.y) * g0.w * silu_f(bf_hi(zv.y)));
            w.z = cvt_pk_bf16(bf_lo(yv.z) * g1.x * silu_f(bf_lo(zv.z)), bf_hi(yv.z) * g1.y * silu_f(bf_hi(zv.z)));
            w.w = cvt_pk_bf16(bf_lo(yv.w) * g1.z * silu_f(bf_lo(zv.w)), bf_hi(yv.w) * g1.w * silu_f(bf_hi(zv.w)));
            *(u32x4*)(Ob + off) = w;
        }
    }
    __syncthreads();
}
template <int VAR> __device__ __forceinline__ void attn_phase(unsigned char* ws, bf16_t* Ob, const bf16_t* Zb, const float* lamvec, const float* subln, float lam_init, LAS unsigned char* lds, int G, int vcu) {
    const int lane = threadIdx.x & 63;
    const float pa = wave_sum(lamvec[lane] * lamvec[64 + lane]), pb = wave_sum(lamvec[128 + lane] * lamvec[192 + lane]);
    const float lam = __expf(pa) - __expf(pb) + lam_init;
    const bf16_t* QO = (const bf16_t*)(ws + WS_H5 + 4 * SLOT); const bf16_t* Kb = (const bf16_t*)(ws + WS_H5 + 2 * SLOT); const bf16_t* Vt = (const bf16_t*)(ws + WS_H5 + 3 * SLOT);
    if (G == 256) {
        const int x = vcu >> 5, j = vcu & 31, g4 = j >> 3, p = j & 7;
        for (int i = 0; i < 8; ++i) { const int bh = x * 16 + (i >> 1) * 4 + g4; const int qb = (i & 1) ? p : 15 - p;
            attn_unit<VAR>(bh >> 3, bh & 7, qb, QO, Ob, Kb, Vt, Zb, subln, lam, 1.0f - lam_init, lds); }
    } else {
        for (int u = vcu; u < 2048; u += G) attn_unit<VAR>(u >> 7, (u >> 4) & 7, u & 15, QO, Ob, Kb, Vt, Zb, subln, lam, 1.0f - lam_init, lds);
    }
}
}


#define XB_TMO      128
#define XB_XCNT(j)  (256  + 64 * (j))
#define XB_XSUB(j)  (1280 + 64 * (j))
#define XB_XGEN(j)  (2304 + 64 * (j))
#define XB_TOP      3328
#define XB_TOPGEN   3392
#define XCD_BAR_WORDS 3456
#define XB_SPIN_CAP (1u << 18)
__device__ __forceinline__ unsigned xb_ld(unsigned* p)              { return __hip_atomic_load(p, __ATOMIC_RELAXED, __HIP_MEMORY_SCOPE_AGENT); }
__device__ __forceinline__ unsigned xb_add(unsigned* p, unsigned v) { return __hip_atomic_fetch_add(p, v, __ATOMIC_RELAXED, __HIP_MEMORY_SCOPE_AGENT); }
__device__ __forceinline__ unsigned xb_xcc_id() { return (unsigned)__builtin_amdgcn_s_getreg((3 << 11) | 20) & 0xFu; }
#define XB_SPIN(cond, bar) do { unsigned _sp = 0; while (cond) { __builtin_amdgcn_s_sleep(1); \
    if ((++_sp & 255u) == 0u) { if (xb_ld(&(bar)[XB_TMO])) break; if (_sp > XB_SPIN_CAP) { atomicAdd(&(bar)[XB_TMO], 1u); break; } } } } while (0)
struct XcdBarrier { unsigned* bar; unsigned x; volatile LAS unsigned* st; };
__device__ __forceinline__ XcdBarrier xcd_barrier_post(unsigned* bar, volatile LAS unsigned* st) {
    XcdBarrier b; b.bar = bar; b.x = xb_xcc_id(); b.st = st;
    if (threadIdx.x == 0) (void)xb_add(&bar[XB_XCNT(b.x)], 1u);
    return b;
}
__device__ __forceinline__ void xcd_barrier_complete(unsigned* bar, unsigned x, unsigned& nloc, unsigned& nx) {
    const unsigned G = gridDim.x * gridDim.y * gridDim.z;
    unsigned sum, cnt, mine, sp = 0u;
    for (;;) {
        sum = 0u; cnt = 0u; mine = 0u;
#pragma unroll
        for (unsigned j = 0; j < 16; ++j) { const unsigned c = xb_ld(&bar[XB_XCNT(j)]); sum += c; cnt += (c > 0u) ? 1u : 0u; mine = (j == x) ? c : mine; }
        if (sum == G) break;
        __builtin_amdgcn_s_sleep(1);
        if ((++sp & 255u) == 0u) { if (xb_ld(&bar[XB_TMO])) break; if (sp > XB_SPIN_CAP) { atomicAdd(&bar[XB_TMO], 1u); break; } }
    }
    nloc = mine > 0u ? mine : 1u; nx = cnt > 0u ? cnt : 1u;
}
__device__ __forceinline__ void xcd_barrier(const XcdBarrier& b) {
    asm volatile("s_waitcnt vmcnt(0)" ::: "memory");
    __syncthreads();
    if (threadIdx.x == 0) {
        unsigned* bar = b.bar;
        __builtin_amdgcn_s_waitcnt(0);
        unsigned nloc = b.st[0], nx = b.st[1];
        if (nloc == 0u) { xcd_barrier_complete(bar, b.x, nloc, nx); b.st[0] = nloc; b.st[1] = nx; }
        const unsigned old = xb_add(&bar[XB_XSUB(b.x)], 1u);
        const unsigned gen = old / nloc;
        if (old + 1u == (gen + 1u) * nloc) {
            __builtin_amdgcn_fence(__ATOMIC_RELEASE, "agent");
            asm volatile("s_waitcnt vmcnt(0)" ::: "memory");
            const unsigned og = xb_add(&bar[XB_TOP], 1u);
            const unsigned tg = og / nx;
            if (og + 1u == (tg + 1u) * nx) xb_add(&bar[XB_TOPGEN], 1u);
            else XB_SPIN(xb_ld(&bar[XB_TOPGEN]) == tg, bar);
            __builtin_amdgcn_fence(__ATOMIC_ACQUIRE, "agent");
            xb_add(&bar[XB_XGEN(b.x)], 1u);
            asm volatile("s_waitcnt vmcnt(0)" ::: "memory");
        } else {
            XB_SPIN(xb_ld(&bar[XB_XGEN(b.x)]) == gen, bar);
            __builtin_amdgcn_fence(__ATOMIC_ACQUIRE, "agent");
            asm volatile("s_waitcnt vmcnt(0)" ::: "memory");
        }
    }
    __syncthreads();
}

__global__ void __launch_bounds__(512) fwd_megakernel(Args a) {
    extern __shared__ __attribute__((aligned(16))) unsigned char lds_raw[];
    LAS unsigned char* lds = (LAS unsigned char*)lds_raw;
    cg::grid_group grid = cg::this_grid();
    const int G = gridDim.x, bx = blockIdx.x;
    const int vcu = (G % 8 == 0) ? (bx % 8) * (G / 8) + bx / 8 : bx;
    unsigned char* ws = a.ws;
    const int lo = a.ph_lo, hi = a.ph_hi;
    if (threadIdx.x < 64) ((LAS unsigned*)(lds + LDS_MISC))[threadIdx.x] = 0u;
    __syncthreads();
    XcdBarrier xbar = xcd_barrier_post((unsigned*)(ws + WS_CTL), (volatile LAS unsigned*)(lds + LDS_MISC));
    bf16_t* H5 = (bf16_t*)(ws + WS_H5);
    const float* ADA = (const float*)(ws + WS_ADA); const float* KVADA = (const float*)(ws + WS_KVADA);
    bf16_t* GW16 = (bf16_t*)(ws + WS_GW); float* GW32 = (float*)(ws + WS_GW);
    bf16_t* OUT16 = (bf16_t*)a.out;
#ifndef PROBE_VAR
#define PROBE9
#define PROBE13
#else
#define PROBE9 att::attn_phase<PROBE_VAR>(ws, OUT16 + (size_t)M * 1024, OUT16, a.in[15], a.in[16], a.lam_init[0], lds, G, vcu);
#define PROBE13 att::attn_phase<PROBE_VAR>(ws, OUT16 + (size_t)M * 1024, OUT16, a.in[15] + 256, a.in[16] + 128, a.lam_init[1], lds, G, vcu);
#endif
#define IN(k) (lo <= (k) && (k) < hi)
#define SEAM(k) do { if ((k) + 1 < hi) { if (hi > 1000) grid.sync(); else xcd_barrier(xbar); } } while (0)
    if (IN(0)) { phase_p0a(a, lds, G, vcu, true, 8192, 11264); SEAM(0); }
    if (IN(1)) {
        { SchedFold S{ws, G, vcu}; pg8::gemm_phase(lds, 512, S); }
        phase_p0a(a, lds, G, vcu, false, 0, 8192);
        __syncthreads();
        phase_e_pool<false>(a.in[0], nullptr, nullptr, nullptr, nullptr, ADA + 0 * 16 * 3072, a.in[4] + 0 * D, H5, lds, G, vcu);
        SEAM(1);
    }
    if (IN(2)) { SchedA1 S{ws, OUT16, a.in[8] + 0 * 2048, 0, G, vcu}; pg8::gemm_phase(lds, 1024, S); SEAM(2); }
    if (IN(3)) { SchedN1024 S{OUT16, (const bf16_t*)(ws + WS_WOUT), GW16, 2048, G, vcu}; pg8::gemm_phase(lds, 2048, S); SEAM(3); }
    if (IN(4)) { phase_e_pool<true>(a.in[0], GW16, a.out, ADA + 0 * 16 * 3072, a.in[5] + 0 * D, ADA + 1 * 16 * 3072, a.in[4] + 1 * D, H5, lds, G, vcu); SEAM(4); }
    if (IN(5)) { SchedA1 S{ws, GW16, a.in[8] + 1 * 2048, 1, G, vcu}; pg8::gemm_phase(lds, 1024, S); SEAM(5); }
    if (IN(6)) { SchedN1024 S{GW16, (const bf16_t*)(ws + WS_WOUT) + (size_t)1024 * 2048, H5 + (size_t)4 * M * 1024, 2048, G, vcu}; pg8::gemm_phase(lds, 2048, S); SEAM(6); }
    if (IN(7)) { phase_e_rows<true, true>(a.out, H5 + (size_t)4 * M * 1024, GW32, ADA + 1 * 16 * 3072, a.in[5] + 1 * D, ADA + 2 * 16 * 3072, a.in[4] + 2 * D, H5,
                              KVADA, a.in[10], H5 + (size_t)1 * M * 1024, G, vcu); SEAM(7); }
    if (IN(8)) { SchedB1 S{ws, (const bf16_t*)(ws + WS_WBIN), OUT16, 1, G, vcu}; pg8::gemm_phase(lds, 1024, S); SEAM(8); }
    if (IN(9)) { att::attn_phase<0>(ws, H5, OUT16, a.in[15], a.in[16], a.lam_init[0], lds, G, vcu); PROBE9 SEAM(9); }
    if (IN(10)) { SchedN1024 S{H5, (const bf16_t*)(ws + WS_WBOUT), OUT16 + (size_t)M * 1024, 1024, G, vcu}; pg8::gemm_phase(lds, 1024, S); SEAM(10); }
    if (IN(11)) { phase_e_rows<true, true>(GW32, OUT16 + (size_t)M * 1024, GW32, ADA + 2 * 16 * 3072, a.in[5] + 2 * D, ADA + 3 * 16 * 3072, a.in[4] + 3 * D, H5,
                               nullptr, nullptr, nullptr, G, vcu); SEAM(11); }
    if (IN(12)) { SchedB1 S{ws, (const bf16_t*)(ws + WS_WBIN) + (size_t)2048 * 1024, OUT16, 0, G, vcu}; pg8::gemm_phase(lds, 1024, S); SEAM(12); }
    if (IN(13)) { att::attn_phase<0>(ws, H5, OUT16, a.in[15] + 256, a.in[16] + 128, a.lam_init[1], lds, G, vcu); PROBE13 SEAM(13); }
    if (IN(14)) { SchedN1024 S{H5, (const bf16_t*)(ws + WS_WBOUT) + (size_t)1024 * 1024, H5 + (size_t)1 * M * 1024, 1024, G, vcu}; pg8::gemm_phase(lds, 1024, S); SEAM(14); }
    if (IN(15)) { phase_e_rows<true, false>(GW32, H5 + (size_t)1 * M * 1024, a.out, ADA + 3 * 16 * 3072, a.in[5] + 3 * D, nullptr, nullptr, nullptr,
                               nullptr, nullptr, nullptr, G, vcu); }
#undef IN
#undef SEAM
}

#ifndef MK_PER_PHASE
#define MK_PER_PHASE 0
#endif

extern "C" void kernel_launch(void* const* d_in, const int* in_sizes, int n_in, void* d_out, int out_size, void* d_ws, size_t ws_size, hipStream_t stream) {
    static int grid = 0;
    if (grid == 0) {
        if (n_in != 18 || out_size != M * D || ws_size < WS_END) { fprintf(stderr, "kernel_launch: unexpected shapes (n_in %d out %d ws %zu)\n", n_in, out_size, ws_size); grid = -1; return; }
        int dev = 0, cus = 0, per_cu = 0;
        (void)hipGetDevice(&dev);
        (void)hipDeviceGetAttribute(&cus, hipDeviceAttributeMultiprocessorCount, dev);
        (void)hipFuncSetAttribute((const void*)fwd_megakernel, hipFuncAttributeMaxDynamicSharedMemorySize, LDS_BYTES);
        (void)hipOccupancyMaxActiveBlocksPerMultiprocessor(&per_cu, (const void*)fwd_megakernel, 512, LDS_BYTES);
        if (per_cu < 1) { fprintf(stderr, "kernel_launch: occupancy query says %d blocks/CU\n", per_cu); grid = -1; return; }
        grid = cus;
    }
    if (grid < 0) return;
    Args a{};
    for (int i = 0; i < 18; ++i) a.in[i] = (const float*)d_in[i];
    a.out = (float*)d_out; a.ws = (unsigned char*)d_ws;
    a.lam_init[0] = (float)(0.8 - 0.6 * std::exp(-0.3 * 2.0)); a.lam_init[1] = (float)(0.8 - 0.6 * std::exp(-0.3 * 3.0));
#if MK_PER_PHASE
    for (int p = 0; p < 16; ++p) { a.ph_lo = p; a.ph_hi = p + 1; hipLaunchKernelGGL(fwd_megakernel, dim3(grid), dim3(512), LDS_BYTES, stream, a); }
#else
    a.ph_lo = 0; a.ph_hi = 16;
    (void)hipMemsetAsync((char*)d_ws + WS_CTL, 0, CTL_BYTES, stream);
    void* args[] = {&a};
    hipError_t e = hipLaunchCooperativeKernel((const void*)fwd_megakernel, dim3(grid), dim3(512), args, LDS_BYTES, stream);
    if (e != hipSuccess) fprintf(stderr, "cooperative launch failed: %s (grid %d)\n", hipGetErrorString(e), grid);
#endif
}
```

```cpp
#include <hip/hip_runtime.h>
#include <hip/hip_cooperative_groups.h>
#include <cstdio>
#include <cstdint>
#include <cmath>
namespace cg = cooperative_groups;

#define LAS __attribute__((address_space(3)))
typedef unsigned short bf16_t;
typedef short bf16x8 __attribute__((ext_vector_type(8)));
typedef short s16x4 __attribute__((ext_vector_type(4)));
typedef float f32x4 __attribute__((ext_vector_type(4)));
typedef float f32x16 __attribute__((ext_vector_type(16)));
typedef unsigned u32x4 __attribute__((ext_vector_type(4)));
typedef unsigned u32x2 __attribute__((ext_vector_type(2)));

constexpr int M = 32768, D = 1024, SEQ = 2048, NB = 16;
constexpr float EPS = 1e-6f, SUBLN_EPS = 1e-5f;
constexpr float C2 = 0.125f * 1.4426950408889634f;

constexpr size_t MiB = 1u << 20;
constexpr size_t WS_WA = 0;
constexpr size_t WS_WOUT = 16 * MiB;
constexpr size_t WS_WKV = 24 * MiB;
constexpr size_t WS_WBIN = 28 * MiB;
constexpr size_t WS_WBOUT = 36 * MiB;
constexpr size_t WS_ADA = 40 * MiB;
constexpr size_t WS_KVADA = 41 * MiB;
constexpr size_t WS_CTL = 44 * MiB;
constexpr size_t CTL_BYTES = 65536;
constexpr size_t WS_H5 = 48 * MiB;
constexpr size_t SLOT = 64 * MiB;
constexpr size_t WS_GW = 368 * MiB;
constexpr size_t WS_WU = WS_GW;
constexpr size_t WS_WGT = WS_GW + 8 * MiB;
constexpr size_t WS_END = 496 * MiB;
constexpr int LDS_MISC = 131072;
constexpr int LDS_BYTES = 131072 + 256;

typedef float f32x2_t __attribute__((ext_vector_type(2))); typedef __bf16 bf16x2_t __attribute__((ext_vector_type(2)));
__device__ __forceinline__ unsigned cvt_pk_bf16(float lo, float hi) { const f32x2_t v = {lo, hi}; const bf16x2_t b = __builtin_convertvector(v, bf16x2_t); return __builtin_bit_cast(unsigned, b); }
__device__ __forceinline__ float bf_lo(unsigned w) { return __uint_as_float(w << 16); }
__device__ __forceinline__ float bf_hi(unsigned w) { return __uint_as_float(w & 0xffff0000u); }
template <int CTRL, int RMASK> __device__ __forceinline__ float dpp_add(float v) {
    const int r = __builtin_amdgcn_update_dpp(0, __float_as_int(v), CTRL, RMASK, 0xF, false);
    return v + __int_as_float(r);
}
__device__ __forceinline__ float wave_sum(float v) {
    v = dpp_add<0xB1, 0xF>(v);
    v = dpp_add<0x4E, 0xF>(v);
    v = dpp_add<0x141, 0xF>(v);
    v = dpp_add<0x140, 0xF>(v);
    v = dpp_add<0x142, 0xA>(v);
    v = dpp_add<0x143, 0xC>(v);
    return __int_as_float(__builtin_amdgcn_readlane(__float_as_int(v), 63));
}
__device__ __forceinline__ float silu_f(float v) { return v * __builtin_amdgcn_rcpf(1.0f + __builtin_amdgcn_exp2f(-1.4426950408889634f * v)); }

namespace pg8 {
constexpr int BM = 256, BK = 64, HALF = 128, HTB = HALF * BK * 2, STAGE_BYTES = 8 * HTB;
__host__ __device__ __forceinline__ int lds_byte(int r, int c) { const int st = (r >> 4) * 2 + (c >> 5), rr = r & 15, cc = c & 31, ob = rr * 64 + cc * 2; return st * 1024 + (ob ^ (((ob >> 9) & 1) << 5)); }
__host__ __device__ __forceinline__ void stage_rc(int b, int& R, int& C) { const int st = b / 1024, sb = b % 1024, swz = sb ^ (((sb >> 9) & 1) << 5); R = (st >> 1) * 16 + swz / 64; C = (st & 1) * 32 + (swz % 64) / 2; }
__host__ __device__ __forceinline__ int perm32(int rho) { const int n = rho >> 4, i = rho & 15; return 8 * (i >> 2) + 4 * n + (i & 3); }

struct Unit { const char* A; const char* B; bf16_t* O; const float* aux; int ldc; float scale; int mode; int bjs; };

__device__ __forceinline__ void epilogue(const f32x4 (&acc)[2][2][4][2], const Unit& u, int wr, int wc, int fr, int fq) {
    const int col0 = wc * 32 + 8 * fq;
    f32x4 av[2][2];
    if (u.mode == 2) {
#pragma unroll
        for (int bj = 0; bj < 2; ++bj)
#pragma unroll
            for (int n = 0; n < 2; ++n) av[bj][n] = *(const f32x4*)(u.aux + col0 + bj * HALF + 4 * n);
    }
#pragma unroll
    for (int ai = 0; ai < 2; ++ai)
#pragma unroll
        for (int m = 0; m < 4; ++m) {
            bf16_t* rowp = u.O + (size_t)(ai * HALF + wr * 64 + m * 16 + fr) * u.ldc + col0;
#pragma unroll
            for (int bj = 0; bj < 2; ++bj) {
                f32x4 v0 = acc[ai][bj][m][0], v1 = acc[ai][bj][m][1];
                if (u.mode == 0) { v0 = v0 * u.scale; v1 = v1 * u.scale; }
                else if (u.mode == 1) {
#pragma unroll
                    for (int e = 0; e < 4; ++e) { v0[e] = silu_f(v0[e]); v1[e] = silu_f(v1[e]); }
                } else {
                    const u32x4 g = *(const u32x4*)(rowp + (size_t)bj * u.bjs);
                    v0 = v0 * av[bj][0]; v1 = v1 * av[bj][1];
                    v0[0] *= bf_lo(g.x); v0[1] *= bf_hi(g.x); v0[2] *= bf_lo(g.y); v0[3] *= bf_hi(g.y);
                    v1[0] *= bf_lo(g.z); v1[1] *= bf_hi(g.z); v1[2] *= bf_lo(g.w); v1[3] *= bf_hi(g.w);
                }
                u32x4 w; w.x = cvt_pk_bf16(v0[0], v0[1]); w.y = cvt_pk_bf16(v0[2], v0[3]); w.z = cvt_pk_bf16(v1[0], v1[1]); w.w = cvt_pk_bf16(v1[2], v1[3]);
                *(u32x4*)(rowp + (size_t)bj * u.bjs) = w;
            }
        }
}

template <class Sched>
__device__ __forceinline__ void gemm_phase(LAS unsigned char* lds, const int K, const Sched& S) {
    const int tid = threadIdx.x, wid = __builtin_amdgcn_readfirstlane(tid >> 6), lane = tid & 63, wr = wid >> 2, wc = wid & 3, fr = lane & 15, fq = lane >> 4;
    const int nt = K / BK;
    unsigned voffA[2], voffB[2];
#pragma unroll
    for (int i = 0; i < 2; ++i) { int R, C; stage_rc(tid * 16 + i * 8192, R, C); const int Rb = (R & ~31) + perm32(R & 31);
        voffA[i] = (unsigned)(R * K + C) * 2u; voffB[i] = (unsigned)(Rb * K + C) * 2u; }
    const size_t kstep = (size_t)(BK * 2);
    const size_t hstep = (size_t)HALF * K * 2;
    const unsigned ldsw = (unsigned)wid * 1024u;
    const int aoff = lds_byte(wr * 64 + fr, fq * 8), boff = lds_byte(wc * 32 + fr, fq * 8);
#define PG8_SA(b, h) (((b) * 2 + (h)) * HTB)
#define PG8_SB(b, h) ((4 + (b) * 2 + (h)) * HTB)
#define PG8_STAGE(bufoff, gbase, voff) do { _Pragma("unroll") for (int _i = 0; _i < 2; ++_i) \
        __builtin_amdgcn_global_load_lds((const unsigned*)((const char*)(gbase) + (voff)[_i]), (LAS unsigned*)(lds + (bufoff) + ldsw + _i * 8192), 16, 0, 0); } while (0)
#define PG8_LDA(dst, b, h) do { _Pragma("unroll") for (int m = 0; m < 4; ++m) _Pragma("unroll") for (int k = 0; k < 2; ++k) dst[m][k] = *(const LAS bf16x8*)(lds + PG8_SA(b, h) + aoff + m * 2048 + k * 1024); } while (0)
#define PG8_LDB(dst, b, h) do { _Pragma("unroll") for (int n = 0; n < 2; ++n) _Pragma("unroll") for (int k = 0; k < 2; ++k) dst[n][k] = *(const LAS bf16x8*)(lds + PG8_SB(b, h) + boff + n * 2048 + k * 1024); } while (0)
#define PG8_MMA(ai, bj, At, Bt) do { __builtin_amdgcn_s_setprio(1); _Pragma("unroll") for (int m = 0; m < 4; ++m) _Pragma("unroll") for (int n = 0; n < 2; ++n) _Pragma("unroll") for (int k = 0; k < 2; ++k) \
        acc[ai][bj][m][n] = __builtin_amdgcn_mfma_f32_16x16x32_bf16(Bt[n][k], At[m][k], acc[ai][bj][m][n], 0, 0, 0); __builtin_amdgcn_s_setprio(0); } while (0)
#define PG8_WAIT_V(n) asm volatile("s_waitcnt vmcnt(" #n ")" ::: "memory")
#define PG8_WAIT_L(n) asm volatile("s_waitcnt lgkmcnt(" #n ")" ::: "memory")
#define PG8_BAR __builtin_amdgcn_s_barrier()
#define PG8_SCHED __builtin_amdgcn_sched_barrier(0)
    Unit cur, nxt; int ui = 0;
    if (!S.next(0, cur)) return;
    f32x4 acc[2][2][4][2];
#pragma unroll
    for (int a = 0; a < 2; ++a)
#pragma unroll
        for (int b = 0; b < 2; ++b)
#pragma unroll
            for (int m = 0; m < 4; ++m)
#pragma unroll
                for (int n = 0; n < 2; ++n) acc[a][b][m][n] = (f32x4){0.f, 0.f, 0.f, 0.f};
    bf16x8 At[4][2], B0[2][2], B1[2][2];
    const char* cA = cur.A; const char* cB = cur.B;
    PG8_STAGE(PG8_SB(0, 0), cB, voffB); PG8_STAGE(PG8_SB(0, 1), cB + hstep, voffB); PG8_STAGE(PG8_SA(0, 0), cA, voffA); PG8_STAGE(PG8_SA(0, 1), cA + hstep, voffA);
    if (wr == 1) PG8_BAR;
    PG8_WAIT_V(2); PG8_BAR;
    PG8_STAGE(PG8_SB(1, 0), cB + kstep, voffB); PG8_STAGE(PG8_SA(1, 0), cA + kstep, voffA); PG8_STAGE(PG8_SB(1, 1), cB + hstep + kstep, voffB);
    PG8_WAIT_V(6); PG8_BAR;
    for (;;) {
        const bool has_next = S.next(ui + 1, nxt);
        const char* nA = has_next ? nxt.A : cA; const char* nB = has_next ? nxt.B : cB;
        for (int t = 0; t < nt; t += 2) {
            const bool last = (t == nt - 2);
            const char* a1 = cA + (size_t)(t + 1) * kstep;
            const char* a2 = last ? nA : cA + (size_t)(t + 2) * kstep; const char* b2 = last ? nB : cB + (size_t)(t + 2) * kstep;
            const char* a3 = a2 + kstep; const char* b3 = b2 + kstep;
            PG8_LDB(B0, 0, 0); PG8_LDB(B1, 0, 1); PG8_SCHED; PG8_LDA(At, 0, 0); PG8_STAGE(PG8_SA(1, 1), a1 + hstep, voffA);
            PG8_WAIT_V(8); PG8_WAIT_L(0); PG8_BAR; PG8_MMA(0, 0, At, B0); PG8_MMA(0, 1, At, B1); PG8_BAR; PG8_SCHED;
            PG8_LDA(At, 0, 1); PG8_STAGE(PG8_SB(0, 0), b2, voffB); PG8_STAGE(PG8_SB(0, 1), b2 + hstep, voffB); PG8_STAGE(PG8_SA(0, 0), a2, voffA);
            PG8_WAIT_V(8); PG8_WAIT_L(0); PG8_BAR; PG8_MMA(1, 0, At, B0); PG8_MMA(1, 1, At, B1); PG8_BAR; PG8_SCHED;
            PG8_LDB(B0, 1, 0); PG8_LDB(B1, 1, 1); PG8_SCHED; PG8_LDA(At, 1, 0); PG8_STAGE(PG8_SA(0, 1), a2 + hstep, voffA);
            PG8_WAIT_V(8); PG8_WAIT_L(0); PG8_BAR; PG8_MMA(0, 0, At, B0); PG8_MMA(0, 1, At, B1); PG8_BAR; PG8_SCHED;
            PG8_LDA(At, 1, 1); PG8_STAGE(PG8_SB(1, 0), b3, voffB); PG8_STAGE(PG8_SB(1, 1), b3 + hstep, voffB); PG8_STAGE(PG8_SA(1, 0), a3, voffA);
            PG8_WAIT_V(8); PG8_WAIT_L(0); PG8_BAR; PG8_MMA(1, 0, At, B0); PG8_MMA(1, 1, At, B1); PG8_BAR; PG8_SCHED;
        }
        if (wr == 0) PG8_BAR;
        epilogue(acc, cur, wr, wc, fr, fq);
        if (!has_next) break;
#pragma unroll
        for (int a = 0; a < 2; ++a)
#pragma unroll
            for (int b = 0; b < 2; ++b)
#pragma unroll
                for (int m = 0; m < 4; ++m)
#pragma unroll
                    for (int n = 0; n < 2; ++n) acc[a][b][m][n] = (f32x4){0.f, 0.f, 0.f, 0.f};
        cur = nxt; cA = nA; cB = nB; ++ui;
        if (wr == 1) PG8_BAR;
    }
    PG8_WAIT_V(0);
    PG8_BAR;
#undef PG8_SA
#undef PG8_SB
#undef PG8_STAGE
#undef PG8_LDA
#undef PG8_LDB
#undef PG8_MMA
#undef PG8_WAIT_V
#undef PG8_WAIT_L
#undef PG8_BAR
#undef PG8_SCHED
}
}

struct Args {
    const float* in[18]; float* out; unsigned char* ws;
    float lam_init[2]; int ph_lo, ph_hi;
};

struct SchedFold {
    unsigned char* ws; int G, c;
    __device__ __forceinline__ bool next(int i, pg8::Unit& u) const {
        const int L = i * G + c; if (L >= 64) return false;
        const int l = L >> 5, g = (L >> 3) & 3, pm = (L >> 2) & 1, pn = L & 3;
        u.A = (const char*)(ws + WS_WGT) + ((size_t)((l * 4 + g) * 512 + pm * 256) * 512) * 2;
        u.B = (const char*)(ws + WS_WU) + ((size_t)((l * 4 + g) * 1024 + pn * 256) * 512) * 2;
        u.O = (bf16_t*)(ws + WS_WA) + (size_t)l * 4096 * 1024 + (size_t)(g * 512 + pm * 256) * 1024 + pn * 256;
        u.ldc = 1024; u.scale = 1.f; u.mode = 0; u.aux = nullptr; u.bjs = 128; return true;
    }
};
struct SchedA1 {
    unsigned char* ws; bf16_t* Gbuf; const float* ch_scale; int l, G, c;
    __device__ __forceinline__ bool next(int i, pg8::Unit& u) const {
        const int L = (i >> 1) * G + c; if (L >= 1024) return false;
        const int pm = (L >> 5) * 4 + (L & 3), jn = (L >> 2) & 7, kind = i & 1;
        const bf16_t* H5 = (const bf16_t*)(ws + WS_H5);
        const bf16_t* WA = (const bf16_t*)(ws + WS_WA) + (size_t)l * 4096 * 1024;
        const int slot = kind ? 1 + (jn >> 1) : 0;
        u.A = (const char*)(H5 + (size_t)slot * M * 1024 + (size_t)pm * 256 * 1024);
        u.B = (const char*)(WA + (size_t)((kind ? 0 : 2048) + jn * 256) * 1024);
        u.O = Gbuf + (size_t)pm * 256 * 2048 + jn * 256; u.ldc = 2048; u.scale = 1.f; u.mode = kind ? 2 : 1; u.aux = ch_scale + jn * 256; u.bjs = 128; return true;
    }
};
struct SchedN1024 {
    const bf16_t* A; const bf16_t* Bt; bf16_t* O; int K, G, c;
    __device__ __forceinline__ bool next(int i, pg8::Unit& u) const {
        const int L = i * G + c; if (L >= 512) return false;
        const int pm = (L >> 5) * 8 + (L & 7), pn = (L >> 3) & 3;
        u.A = (const char*)(A + (size_t)pm * 256 * K); u.B = (const char*)(Bt + (size_t)pn * 256 * K);
        u.O = O + (size_t)pm * 256 * 1024 + pn * 256; u.ldc = 1024; u.scale = 1.f; u.mode = 0; u.aux = nullptr; u.bjs = 128; return true;
    }
};
struct SchedB1 {
    unsigned char* ws; const bf16_t* Wbin; bf16_t* Zbuf; int with_kv, G, c;
    __device__ __forceinline__ bool next(int i, pg8::Unit& u) const {
        int L = i * G + c; const int tot = with_kv ? 2048 : 1024; if (L >= tot) return false;
        const bf16_t* H5 = (const bf16_t*)(ws + WS_H5);
        const bf16_t* h = H5; const bf16_t* hk = H5 + (size_t)M * 1024;
        bf16_t* Kb = (bf16_t*)(ws + WS_H5 + 2 * SLOT); bf16_t* Vt = (bf16_t*)(ws + WS_H5 + 3 * SLOT); bf16_t* Qb = (bf16_t*)(ws + WS_H5 + 4 * SLOT);
        const bf16_t* Wkv = (const bf16_t*)(ws + WS_WKV);
        u.mode = 0; u.aux = nullptr; u.scale = 1.f; u.ldc = 1024; u.bjs = 128;
        if (L < 1024) {
            const int pm = (L >> 5) * 4 + (L & 3), pn = (L >> 2) & 7;
            u.A = (const char*)(h + (size_t)pm * 256 * 1024); u.B = (const char*)(Wbin + (size_t)pn * 256 * 1024);
            if (pn < 4) { u.O = Qb + (size_t)pm * 256 * 1024 + pn * 256; u.scale = C2; } else { u.O = Zbuf + (size_t)pm * 256 * 1024 + (pn - 4) * 256; }
        } else if (L < 1536) {
            L -= 1024; const int pm = (L >> 5) * 8 + (L & 7), pn = (L >> 3) & 3;
            u.A = (const char*)(hk + (size_t)pm * 256 * 1024); u.B = (const char*)(Wkv + (size_t)pn * 256 * 1024);
            u.O = Kb + ((size_t)((pm >> 3) * 8 + 2 * pn) * 2048 + (pm & 7) * 256) * 128; u.ldc = 128; u.bjs = 2048 * 128;
        } else {
            L -= 1536; const int pn = (L >> 5) * 8 + (L & 7), pm = (L >> 3) & 3;
            u.A = (const char*)(Wkv + (size_t)(1024 + pm * 256) * 1024); u.B = (const char*)(hk + (size_t)pn * 256 * 1024);
            u.O = Vt + ((size_t)((pn >> 3) * 8 + 2 * pm) * 128) * 2048 + (pn & 7) * 256; u.ldc = 2048;
        }
        return true;
    }
};

__device__ __forceinline__ void transpose_item(const float* W, int ldw, int K, bf16_t* WT, LAS float* scr, int kb, int nb, int lane) {
    const int k0 = 64 * kb, n0 = 32 * nb;
    float tv[32];
#pragma unroll
    for (int i = 0; i < 32; ++i) { const int kk = 2 * i + (lane >> 5); tv[i] = W[(size_t)(k0 + kk) * ldw + n0 + (lane & 31)]; }
#pragma unroll
    for (int i = 0; i < 32; ++i) { const int kk = 2 * i + (lane >> 5); scr[kk * 33 + (lane & 31)] = tv[i]; }
    asm volatile("s_waitcnt lgkmcnt(0)" ::: "memory");
    const int c = lane & 7;
#pragma unroll
    for (int j = 0; j < 4; ++j) { const int n = (lane >> 3) + 8 * j; const LAS float* s = scr + (8 * c) * 33 + n;
        u32x4 o; o.x = cvt_pk_bf16(s[0 * 33], s[1 * 33]); o.y = cvt_pk_bf16(s[2 * 33], s[3 * 33]); o.z = cvt_pk_bf16(s[4 * 33], s[5 * 33]); o.w = cvt_pk_bf16(s[6 * 33], s[7 * 33]);
        *(u32x4*)(WT + (size_t)(n0 + n) * K + k0 + 8 * c) = o; }
    asm volatile("s_waitcnt lgkmcnt(0)" ::: "memory");
}

__device__ __forceinline__ void phase_p0a(const Args& a, LAS unsigned char* lds, int G, int vcu, const bool do_gemv, const int it_lo, const int it_hi) {
    const int tid = threadIdx.x, lane = tid & 63, wave = __builtin_amdgcn_readfirstlane(tid >> 6);
    unsigned char* ws = a.ws;
    LAS float* cl = (LAS float*)lds;
    LAS float* red = (LAS float*)(lds + 65536);
    bool cl_ready = false;
    for (int T = vcu; T < (do_gemv ? 224 : 0); T += G) {
        if (!cl_ready) {
            for (int e = tid; e < 16 * 1024; e += 512) cl[e] = silu_f(a.in[1][e]);
            cl_ready = true;
        }
        __syncthreads();
        const int n0 = T * 64; const float* W; const float* bias; float* out; int ldw;
        if (n0 < 12288) { const int l = n0 / 3072, nn = n0 % 3072; W = a.in[2] + (size_t)l * 1024 * 3072 + nn; ldw = 3072; bias = a.in[3] + l * 3072 + nn; out = (float*)(ws + WS_ADA) + (size_t)l * 16 * 3072 + nn; }
        else { const int nn = n0 - 12288; W = a.in[11] + nn; ldw = 2048; bias = a.in[12] + nn; out = (float*)(ws + WS_KVADA) + nn; }
        float acc[16];
#pragma unroll
        for (int b = 0; b < 16; ++b) acc[b] = 0.f;
        const int kbeg = wave * 128;
#pragma unroll 2
        for (int k = kbeg; k < kbeg + 128; k += 4) {
            const float w0 = W[(size_t)(k + 0) * ldw + lane], w1 = W[(size_t)(k + 1) * ldw + lane], w2 = W[(size_t)(k + 2) * ldw + lane], w3 = W[(size_t)(k + 3) * ldw + lane];
#pragma unroll
            for (int b = 0; b < 16; ++b) { const f32x4 cv = *(const LAS f32x4*)(cl + b * 1024 + k); acc[b] += (cv.x * w0 + cv.y * w1) + (cv.z * w2 + cv.w * w3); }
        }
#pragma unroll
        for (int b = 0; b < 16; ++b) red[(wave * 16 + b) * 64 + lane] = acc[b];
        __syncthreads();
#pragma unroll
        for (int bb = 0; bb < 2; ++bb) { const int b = wave + 8 * bb; float s = bias[lane];
#pragma unroll
            for (int w = 0; w < 8; ++w) s += red[(w * 16 + b) * 64 + lane];
            out[(size_t)b * ldw + lane] = s; }
    }
    __syncthreads();
    LAS float* scr = (LAS float*)(lds + wave * 8448);
    const int gw = vcu * 8 + wave, NGW = G * 8;
    bf16_t* WA = (bf16_t*)(ws + WS_WA); bf16_t* WOUT = (bf16_t*)(ws + WS_WOUT); bf16_t* WKV = (bf16_t*)(ws + WS_WKV);
    bf16_t* WBIN = (bf16_t*)(ws + WS_WBIN); bf16_t* WBOUT = (bf16_t*)(ws + WS_WBOUT); bf16_t* WGT = (bf16_t*)(ws + WS_WGT); bf16_t* WU = (bf16_t*)(ws + WS_WU);
    for (int it = it_lo + gw; it < it_hi; it += NGW) {
        int r = it;
        if (r < 2048) { const int l = r >> 10; r &= 1023;
            transpose_item(a.in[6] + (size_t)l * 1024 * 4096 + 2048, 4096, 1024, WA + (size_t)l * 4096 * 1024 + (size_t)2048 * 1024, scr, r >> 6, r & 63, lane); continue; } r -= 2048;
        if (r < 2048) { const int l = r >> 10; r &= 1023;
            transpose_item(a.in[9] + (size_t)l * 2048 * 1024, 1024, 2048, WOUT + (size_t)l * 1024 * 2048, scr, r >> 5, r & 31, lane); continue; } r -= 2048;
        if (r < 1024) { transpose_item(a.in[13], 2048, 1024, WKV, scr, r >> 6, r & 63, lane); continue; } r -= 1024;
        if (r < 2048) { const int j = r >> 10; r &= 1023;
            transpose_item(a.in[14] + (size_t)j * 1024 * 2048, 2048, 1024, WBIN + (size_t)j * 2048 * 1024, scr, r >> 6, r & 63, lane); continue; } r -= 2048;
        if (r < 1024) { const int j = r >> 9; r &= 511;
            transpose_item(a.in[17] + (size_t)j * 1024 * 1024, 1024, 1024, WBOUT + (size_t)j * 1024 * 1024, scr, r >> 5, r & 31, lane); continue; } r -= 1024;
        if (r < 1024) { const int lg = r >> 7; r &= 127;
            transpose_item(a.in[7] + (size_t)lg * 512 * 512, 512, 512, WGT + (size_t)lg * 512 * 512, scr, r >> 4, r & 15, lane); continue; } r -= 1024;
        {
            const int l = r >> 10, k = r & 1023; const float* src = a.in[6] + ((size_t)l * 1024 + k) * 4096;
#pragma unroll
            for (int q = 0; q < 4; ++q) { const int col = q * 512 + lane * 8; const f32x4 v0 = *(const f32x4*)(src + col), v1 = *(const f32x4*)(src + col + 4);
                u32x4 o; o.x = cvt_pk_bf16(v0.x, v0.y); o.y = cvt_pk_bf16(v0.z, v0.w); o.z = cvt_pk_bf16(v1.x, v1.y); o.w = cvt_pk_bf16(v1.z, v1.w);
                *(u32x4*)(WU + ((size_t)(l * 4 + q) * 1024 + k) * 512 + lane * 8) = o; }
        }
    }
}

struct RowP { f32x4 gp[4], sc[4], sh[4]; };
__device__ __forceinline__ void load_rowp(RowP& P, const float* ada_prev  , const float* npost, const float* ada_next, const float* npre, int lane) {
#pragma unroll
    for (int j = 0; j < 4; ++j) {
        const int col = 4 * lane + 256 * j;
        if (ada_prev) P.gp[j] = *(const f32x4*)(ada_prev + 2048 + col) * *(const f32x4*)(npost + col); else P.gp[j] = (f32x4){0.f, 0.f, 0.f, 0.f};
        if (ada_next) { P.sc[j] = *(const f32x4*)(npre + col) * (*(const f32x4*)(ada_next + 1024 + col) + 1.0f); P.sh[j] = *(const f32x4*)(ada_next + col); }
        else { P.sc[j] = (f32x4){0.f, 0.f, 0.f, 0.f}; P.sh[j] = P.sc[j]; }
    }
}
struct RowIn { f32x4 x[4]; u32x2 y[4]; };
template <bool XBF = false>
__device__ __forceinline__ void row_load(RowIn& R, const void* xrow_, const bf16_t* yrow, int lane) {
    if (XBF) { const bf16_t* xrow = (const bf16_t*)xrow_;
#pragma unroll
        for (int j = 0; j < 4; ++j) { const u32x2 w = *(const u32x2*)(xrow + 4 * lane + 256 * j); R.x[j] = (f32x4){bf_lo(w.x), bf_hi(w.x), bf_lo(w.y), bf_hi(w.y)}; }
    } else { const float* xrow = (const float*)xrow_;
#pragma unroll
        for (int j = 0; j < 4; ++j) R.x[j] = *(const f32x4*)(xrow + 4 * lane + 256 * j); }
    if (yrow) {
#pragma unroll
        for (int j = 0; j < 4; ++j) R.y[j] = *(const u32x2*)(yrow + 4 * lane + 256 * j);
    }
}
__device__ __forceinline__ float row_compute(f32x4 (&xv)[4], const RowIn& R, bool has_y, const RowP& P) {
#pragma unroll
    for (int j = 0; j < 4; ++j) xv[j] = R.x[j];
    if (has_y) {
        f32x4 yv[4]; float s = 0.f;
#pragma unroll
        for (int j = 0; j < 4; ++j) { const u32x2 w = R.y[j]; yv[j] = (f32x4){bf_lo(w.x), bf_hi(w.x), bf_lo(w.y), bf_hi(w.y)};
            s += (yv[j].x * yv[j].x + yv[j].y * yv[j].y) + (yv[j].z * yv[j].z + yv[j].w * yv[j].w); }
        const float ry = __builtin_amdgcn_rsqf(wave_sum(s) * (1.f / 1024.f) + EPS);
#pragma unroll
        for (int j = 0; j < 4; ++j) xv[j] = xv[j] + P.gp[j] * (yv[j] * ry);
    }
    float s2 = 0.f;
#pragma unroll
    for (int j = 0; j < 4; ++j) s2 += (xv[j].x * xv[j].x + xv[j].y * xv[j].y) + (xv[j].z * xv[j].z + xv[j].w * xv[j].w);
    return __builtin_amdgcn_rsqf(wave_sum(s2) * (1.f / 1024.f) + EPS);
}
__device__ __forceinline__ float row_update(f32x4 (&xv)[4], const float* xrow, const bf16_t* yrow, const RowP& P, int lane) {
    RowIn R; row_load(R, xrow, yrow, lane); return row_compute(xv, R, yrow != nullptr, P);
}

template <bool XOB> __device__ __forceinline__ void phase_e_pool(const float* xold, const bf16_t* y, void* xnew_, const float* ada_prev_all  , const float* npost,
                                             const float* ada_next_all, const float* npre, bf16_t* H5, LAS unsigned char* lds, int G, int vcu) {
    const int tid = threadIdx.x, lane = tid & 63, wave = __builtin_amdgcn_readfirstlane(tid >> 6);
    LAS unsigned char* hbuf = lds;
    for (int T = vcu; T < M / 128; T += G) {
        const int m0 = T * 128, b = m0 / SEQ, t0 = m0 % SEQ;
        RowP P; load_rowp(P, ada_prev_all ? ada_prev_all + b * 3072 : nullptr, npost, ada_next_all + b * 3072, npre, lane);
        for (int c = 0; c < 9; ++c) {
#pragma unroll
            for (int rr = 0; rr < 2; ++rr) {
                const int r = wave * 2 + rr, t = t0 - 16 + 16 * c + r, m = m0 - 16 + 16 * c + r, slot = (16 * c + r) & 31;
                LAS unsigned char* hrow = hbuf + slot * 2048;
                if (t < 0) {
#pragma unroll
                    for (int j = 0; j < 4; ++j) *(LAS u32x2*)(hrow + (4 * lane + 256 * j) * 2) = (u32x2){0u, 0u};
                } else {
                    f32x4 xv[4]; const float rx = row_update(xv, xold + (size_t)m * D, y ? y + (size_t)m * D : nullptr, P, lane);
                    if (y && c >= 1) {
                        if (XOB) { bf16_t* xnew = (bf16_t*)xnew_;
#pragma unroll
                            for (int j = 0; j < 4; ++j) *(u32x2*)(xnew + (size_t)m * D + 4 * lane + 256 * j) = (u32x2){cvt_pk_bf16(xv[j].x, xv[j].y), cvt_pk_bf16(xv[j].z, xv[j].w)};
                        } else { float* xnew = (float*)xnew_;
#pragma unroll
                            for (int j = 0; j < 4; ++j) *(f32x4*)(xnew + (size_t)m * D + 4 * lane + 256 * j) = xv[j]; }
                    }
#pragma unroll
                    for (int j = 0; j < 4; ++j) { const f32x4 h = xv[j] * rx * P.sc[j] + P.sh[j];
                        *(LAS u32x2*)(hrow + (4 * lane + 256 * j) * 2) = (u32x2){cvt_pk_bf16(h.x, h.y), cvt_pk_bf16(h.z, h.w)}; }
                }
            }
            __syncthreads();
            if (c >= 1) {
                const int half = tid >> 8, c4 = tid & 255;
                f32x4 hist[23];
#pragma unroll
                for (int i = 0; i < 23; ++i) { const int slot = (16 * c + 8 * half - 15 + i) & 31; const u32x2 w = *(const LAS u32x2*)(hbuf + slot * 2048 + c4 * 8);
                    hist[i] = (f32x4){bf_lo(w.x), bf_hi(w.x), bf_lo(w.y), bf_hi(w.y)}; }
#pragma unroll
                for (int j = 0; j < 8; ++j) {
                    const int rloc = 16 * (c - 1) + 8 * half + j, t = t0 + rloc; const size_t m = (size_t)m0 + rloc;
                    const f32x4 v0 = hist[j + 15];
                    f32x4 s2 = v0 + hist[j + 14];
                    f32x4 s4 = s2 + (hist[j + 13] + hist[j + 12]);
                    f32x4 s8 = s4 + ((hist[j + 11] + hist[j + 10]) + (hist[j + 9] + hist[j + 8]));
                    f32x4 s16 = s8 + (((hist[j + 7] + hist[j + 6]) + (hist[j + 5] + hist[j + 4])) + ((hist[j + 3] + hist[j + 2]) + (hist[j + 1] + hist[j + 0])));
                    const float i2 = 1.f / (float)min(t + 1, 2), i4 = 1.f / (float)min(t + 1, 4), i8 = 1.f / (float)min(t + 1, 8), i16 = 1.f / (float)min(t + 1, 16);
                    const f32x4 o2 = s2 * i2 - v0, o4 = s4 * i4 - v0, o8 = s8 * i8 - v0, o16 = s16 * i16 - v0;
                    bf16_t* dst = H5 + m * 1024 + c4 * 4;
                    *(u32x2*)(dst) = (u32x2){cvt_pk_bf16(v0.x, v0.y), cvt_pk_bf16(v0.z, v0.w)};
                    *(u32x2*)(dst + (size_t)1 * M * 1024) = (u32x2){cvt_pk_bf16(o2.x, o2.y), cvt_pk_bf16(o2.z, o2.w)};
                    *(u32x2*)(dst + (size_t)2 * M * 1024) = (u32x2){cvt_pk_bf16(o4.x, o4.y), cvt_pk_bf16(o4.z, o4.w)};
                    *(u32x2*)(dst + (size_t)3 * M * 1024) = (u32x2){cvt_pk_bf16(o8.x, o8.y), cvt_pk_bf16(o8.z, o8.w)};
                    *(u32x2*)(dst + (size_t)4 * M * 1024) = (u32x2){cvt_pk_bf16(o16.x, o16.y), cvt_pk_bf16(o16.z, o16.w)};
                }
            }
            __syncthreads();
        }
    }
}

template <bool XIB, bool XOB> __device__ __forceinline__ void phase_e_rows(const void* xold_, const bf16_t* y, void* xnew_, const float* ada_prev_all, const float* npost,
                                             const float* ada_next_all, const float* npre, bf16_t* hout,
                                             const float* kvada_all  , const float* kvnorm, bf16_t* hkout, int G, int vcu) {
    const int tid = threadIdx.x, lane = tid & 63, wave = __builtin_amdgcn_readfirstlane(tid >> 6);
    for (int grp = vcu * 8 + wave; grp < M / 16; grp += G * 8) {
        const int m0 = grp * 16, b = m0 / SEQ;
        RowP P; load_rowp(P, ada_prev_all + b * 3072, npost, ada_next_all ? ada_next_all + b * 3072 : nullptr, npre, lane);
        f32x4 ksc[4], ksh[4];
        if (kvada_all) {
#pragma unroll
            for (int j = 0; j < 4; ++j) { const int col = 4 * lane + 256 * j; ksc[j] = *(const f32x4*)(kvnorm + col) * (*(const f32x4*)(kvada_all + b * 2048 + 1024 + col) + 1.0f); ksh[j] = *(const f32x4*)(kvada_all + b * 2048 + col); }
        }
        const size_t xes = XIB ? 2 : 4;
        RowIn Rn; row_load<XIB>(Rn, (const char*)xold_ + (size_t)m0 * D * xes, y + (size_t)m0 * D, lane);
        for (int r = 0; r < 16; ++r) {
            const size_t m = (size_t)m0 + r;
            const RowIn Rc = Rn;
            if (r + 1 < 16) row_load<XIB>(Rn, (const char*)xold_ + (m + 1) * D * xes, y + (m + 1) * D, lane);
            f32x4 xv[4]; const float rx = row_compute(xv, Rc, true, P);
            if (XOB) { bf16_t* xnew = (bf16_t*)xnew_;
#pragma unroll
                for (int j = 0; j < 4; ++j) *(u32x2*)(xnew + m * D + 4 * lane + 256 * j) = (u32x2){cvt_pk_bf16(xv[j].x, xv[j].y), cvt_pk_bf16(xv[j].z, xv[j].w)};
            } else { float* xnew = (float*)xnew_;
#pragma unroll
                for (int j = 0; j < 4; ++j) *(f32x4*)(xnew + m * D + 4 * lane + 256 * j) = xv[j]; }
            if (ada_next_all) {
#pragma unroll
                for (int j = 0; j < 4; ++j) { const f32x4 h = xv[j] * rx * P.sc[j] + P.sh[j];
                    *(u32x2*)(hout + m * D + 4 * lane + 256 * j) = (u32x2){cvt_pk_bf16(h.x, h.y), cvt_pk_bf16(h.z, h.w)}; }
            }
            if (kvada_all) {
#pragma unroll
                for (int j = 0; j < 4; ++j) { const f32x4 h = xv[j] * rx * ksc[j] + ksh[j];
                    *(u32x2*)(hkout + m * D + 4 * lane + 256 * j) = (u32x2){cvt_pk_bf16(h.x, h.y), cvt_pk_bf16(h.z, h.w)}; }
            }
        }
    }
}

namespace att {
constexpr int KSTR = 144, VSTR = 144, K_BYTES = 64 * KSTR, V_OFF = 2 * K_BYTES, STAGE = V_OFF + 128 * VSTR;
constexpr int X_OFF = 0, Y_OFF = 65536, YSTR = 272;
__device__ __forceinline__ float max3f(float a, float b, float c) { return __builtin_fmaxf(__builtin_fmaxf(a, b), c); }
struct Pref { u32x4 rk0, rk1, rv0, rv1; bf16x8 qf[4]; };
__device__ __forceinline__ void attn_prefetch(Pref& pf, int b, int hd, int qb, const bf16_t* QO, const bf16_t* Kb, const bf16_t* Vt) {
    const int tid = threadIdx.x, lane = tid & 63, l32 = lane & 31, hi = lane >> 5, wave = __builtin_amdgcn_readfirstlane(tid >> 6);
    const int mp = wave >> 2, qw = wave & 3;
    const int srow = tid >> 3, sp = tid & 7, vrow = tid >> 2, vq = tid & 3;
    const bf16_t* kg = Kb + ((size_t)(b * 8 + hd) * 2048 + srow) * 128 + sp * 8;
    const bf16_t* vg = Vt + ((size_t)(b * 8 + hd) * 128 + vrow) * 2048 + vq * 16;
    pf.rk0 = *(const u32x4*)(kg); pf.rk1 = *(const u32x4*)(kg + 64); pf.rv0 = *(const u32x4*)(vg); pf.rv1 = *(const u32x4*)(vg + 8);
    const bf16_t* qp = QO + ((size_t)b * SEQ + qb * 128 + 32 * qw + l32) * 1024 + hd * 128 + mp * 64 + hi * 8;
#pragma unroll
    for (int kk = 0; kk < 4; ++kk) pf.qf[kk] = *(const bf16x8*)(qp + kk * 16);
}
template <int VAR> __device__ __forceinline__ void attn_unit(Pref& pf, bool has_next, int nb, int nhd, int nqb, int b, int hd, int qb, const bf16_t* QO, bf16_t* Ob, const bf16_t* Kb, const bf16_t* Vt, const bf16_t* Zb, const float* subln, float lam, float one_m_li, LAS unsigned char* lds) {
    const int tid = threadIdx.x, lane = tid & 63, l32 = lane & 31, hi = lane >> 5, wave = __builtin_amdgcn_readfirstlane(tid >> 6);
    const int mp = wave >> 2, qw = wave & 3;
    const size_t rowbase = (size_t)b * SEQ; const int q0 = qb * 128;
    const int NT = 2 * qb + 2, my_last = 2 * qb + (qw >> 1);
    const int srow = tid >> 3, sp = tid & 7, vrow = tid >> 2, vq = tid & 3;
    const bf16_t* kg = Kb + ((size_t)(b * 8 + hd) * 2048 + srow) * 128 + sp * 8;
    const bf16_t* vg = Vt + ((size_t)(b * 8 + hd) * 128 + vrow) * 2048 + vq * 16;
    const int kl = srow * KSTR + sp * 16, vl = V_OFF + vrow * VSTR + vq * 32;
    bf16x8 qf[4];
#pragma unroll
    for (int kk = 0; kk < 4; ++kk) qf[kk] = pf.qf[kk];
    u32x4 rk0 = pf.rk0, rk1 = pf.rk1, rv0 = pf.rv0, rv1 = pf.rv1;
#define STAGE_LOAD(t) do { const size_t ko = (size_t)(t) * 64 * 128, vo = (size_t)(t) * 64; \
        rk0 = *(const u32x4*)(kg + ko); rk1 = *(const u32x4*)(kg + ko + 64); rv0 = *(const u32x4*)(vg + vo); rv1 = *(const u32x4*)(vg + vo + 8); } while (0)
#define STAGE_STORE(stoff) do { LAS unsigned char* st_ = lds + (stoff); \
        *(LAS u32x4*)(st_ + kl) = rk0; *(LAS u32x4*)(st_ + K_BYTES + kl) = rk1; \
        *(LAS u32x4*)(st_ + vl) = (u32x4){rv0.x, rv0.y, rv1.x, rv1.y}; *(LAS u32x4*)(st_ + vl + 16) = (u32x4){rv0.z, rv0.w, rv1.z, rv1.w}; } while (0)
    STAGE_STORE(0);
    __syncthreads();
    f32x16 o[4];
#pragma unroll
    for (int i = 0; i < 4; ++i) o[i] = (f32x16){0.f, 0.f, 0.f, 0.f, 0.f, 0.f, 0.f, 0.f, 0.f, 0.f, 0.f, 0.f, 0.f, 0.f, 0.f, 0.f};
    f32x16 negm = (f32x16){0.f, 0.f, 0.f, 0.f, 0.f, 0.f, 0.f, 0.f, 0.f, 0.f, 0.f, 0.f, 0.f, 0.f, 0.f, 0.f};
    float mhat = 0.f, lsum = 0.f;
    u32x4 pw[4];
    pw[0] = pw[1] = pw[2] = pw[3] = (u32x4){0u, 0u, 0u, 0u};
    const int koff = mp * K_BYTES + l32 * KSTR + hi * 16, voff = V_OFF + l32 * VSTR + hi * 16;
#define LOADV(stoff, D0, D1) _Pragma("unroll") for (int dvb = D0; dvb < D1; ++dvb) _Pragma("unroll") for (int sj = 0; sj < 4; ++sj) \
        vf[(dvb & 1) * 4 + sj] = *(const LAS bf16x8*)(lds + (stoff) + voff + dvb * 32 * VSTR + sj * 32);
#define PVMMA(D0, D1) _Pragma("unroll") for (int dvb = D0; dvb < D1; ++dvb) _Pragma("unroll") for (int sj = 0; sj < 4; ++sj) \
        o[dvb] = __builtin_amdgcn_mfma_f32_32x32x16_bf16(vf[(dvb & 1) * 4 + sj], __builtin_bit_cast(bf16x8, pw[sj]), o[dvb], 0, 0, 0);
#define PV_ALL(stoff) do { { bf16x8 vf[8]; LOADV(stoff, 0, 2) PVMMA(0, 2) } { bf16x8 vf[8]; LOADV(stoff, 2, 4) PVMMA(2, 4) } } while (0)
#define EXPS(sX, J0) do { \
        _Pragma("unroll") for (int r = 0; r < 16; ++r) { sX[r] = __builtin_amdgcn_exp2f(sX[r]); ps += sX[r]; } \
        _Pragma("unroll") for (int j = 0; j < 2; ++j) \
            pn[J0 + j] = (u32x4){cvt_pk_bf16(sX[8 * j], sX[8 * j + 1]), cvt_pk_bf16(sX[8 * j + 2], sX[8 * j + 3]), cvt_pk_bf16(sX[8 * j + 4], sX[8 * j + 5]), cvt_pk_bf16(sX[8 * j + 6], sX[8 * j + 7])}; \
    } while (0)
#define BAR_LDS() asm volatile("s_waitcnt lgkmcnt(0)\n\ts_barrier" ::: "memory")
    int so_prev = 0, so_cur = 0, so_next = STAGE;
    for (int kt = 0; kt < NT; ++kt) {
        const bool more = (kt + 1 < NT);
        if (more && !(VAR & 1)) STAGE_LOAD(kt + 1);
        if (!(VAR & 2)) {
            {
                const bool act = (kt <= my_last);
                __builtin_amdgcn_s_setprio(2);
                bf16x8 kf[8];
#pragma unroll
                for (int kk = 0; kk < 4; ++kk) { kf[2 * kk] = *(const LAS bf16x8*)(lds + so_cur + koff + kk * 32); kf[2 * kk + 1] = *(const LAS bf16x8*)(lds + so_cur + koff + 32 * KSTR + kk * 32); }
                f32x16 s0 = __builtin_amdgcn_mfma_f32_32x32x16_bf16(kf[0], qf[0], negm, 0, 0, 0);
                f32x16 s1 = __builtin_amdgcn_mfma_f32_32x32x16_bf16(kf[1], qf[0], negm, 0, 0, 0);
#pragma unroll
                for (int kk = 1; kk < 4; ++kk) {
                    s0 = __builtin_amdgcn_mfma_f32_32x32x16_bf16(kf[2 * kk], qf[kk], s0, 0, 0, 0);
                    s1 = __builtin_amdgcn_mfma_f32_32x32x16_bf16(kf[2 * kk + 1], qf[kk], s1, 0, 0, 0);
                }
                float m0 = max3f(s0[0], s0[1], s0[2]), m1 = max3f(s0[8], s0[9], s0[10]), m2 = max3f(s1[0], s1[1], s1[2]), m3 = max3f(s1[8], s1[9], s1[10]);
                m0 = max3f(m0, s0[3], s0[4]); m1 = max3f(m1, s0[11], s0[12]); m2 = max3f(m2, s1[3], s1[4]); m3 = max3f(m3, s1[11], s1[12]);
                m0 = max3f(m0, s0[5], s0[6]); m1 = max3f(m1, s0[13], s0[14]); m2 = max3f(m2, s1[5], s1[6]); m3 = max3f(m3, s1[13], s1[14]);
                m0 = max3f(m0, s0[7], m1); m2 = max3f(m2, s1[7], m3);
                const float lm = max3f(m0, m2, fmaxf(s0[15], s1[15]));
                u32x4 pn[4]; float ps = 0.f, f = 1.0f;
                const bool rare = (kt == 0) || __any(act && lm > 8.0f);
                if (rare) {
                    const float mx = fmaxf(lm, __shfl_xor(lm, 32));
                    const float dl = (kt == 0) ? mx : fmaxf(mx, 0.f);
                    f = __builtin_amdgcn_exp2f(-dl); mhat += dl;
#pragma unroll
                    for (int r = 0; r < 16; ++r) { s0[r] -= dl; s1[r] -= dl; negm[r] = -mhat; }
                }
                __builtin_amdgcn_s_setprio(1);
#define PV_EXP_PATTERN() do { __builtin_amdgcn_sched_group_barrier(0x100, 2, 0); \
        _Pragma("unroll") for (int g_ = 0; g_ < 8; ++g_) { __builtin_amdgcn_sched_group_barrier(0x008, 1, 0); __builtin_amdgcn_sched_group_barrier(0x100, 1, 0); __builtin_amdgcn_sched_group_barrier(0x002, 5, 0); } } while (0)
                { bf16x8 vf[8]; LOADV(so_prev, 0, 2) PVMMA(0, 2) EXPS(s0, 0); asm volatile("" : "+v"(pn[0]), "+v"(pn[1]), "+v"(ps)); PV_EXP_PATTERN(); }
                __builtin_amdgcn_sched_barrier(0);
                { bf16x8 vf[8]; LOADV(so_prev, 2, 4) PVMMA(2, 4) EXPS(s1, 2); asm volatile("" : "+v"(pn[2]), "+v"(pn[3]), "+v"(ps)); PV_EXP_PATTERN(); }
                __builtin_amdgcn_sched_barrier(0);
#undef PV_EXP_PATTERN
                __builtin_amdgcn_s_setprio(0);
                if (rare && kt > 0) {
                    lsum *= f;
#pragma unroll
                    for (int i = 0; i < 4; ++i)
#pragma unroll
                        for (int r = 0; r < 16; ++r) o[i][r] *= f;
                }
                lsum += act ? ps : 0.f;
                const unsigned keep = act ? 0xffffffffu : 0u;
#pragma unroll
                for (int j = 0; j < 4; ++j) pw[j] = (u32x4){pn[j].x & keep, pn[j].y & keep, pn[j].z & keep, pn[j].w & keep};
            }
        }
        if (more && !(VAR & 1)) STAGE_STORE(so_next);
        BAR_LDS();
        so_prev = so_cur; so_cur = so_next; so_next = (so_next == 2 * STAGE) ? 0 : so_next + STAGE;
    }
    if (!(VAR & 2) && NT - 1 <= my_last) PV_ALL(so_prev);
#undef BAR_LDS
#undef EXPS
#undef PV_ALL
#undef STAGE_LOAD
#undef STAGE_STORE
#undef LOADV
#undef PVMMA
    const int fw = wave >> 1, fh = wave & 1, pc = lane & 15;
    u32x4 zpre[4];
#pragma unroll
    for (int i = 0; i < 4; ++i) { const int q = 16 * fh + 4 * i + (lane >> 4); zpre[i] = *(const u32x4*)(Zb + (rowbase + q0 + 32 * fw + q) * 1024 + hd * 128 + 8 * pc); }
    const f32x4 g0 = *(const f32x4*)(subln + 8 * pc), g1 = *(const f32x4*)(subln + 8 * pc + 4);
    if (has_next) attn_prefetch(pf, nb, nhd, nqb, QO, Kb, Vt);
    __syncthreads();
    { const auto rr = __builtin_amdgcn_permlane32_swap(__float_as_uint(lsum), __float_as_uint(lsum), false, false); lsum = __uint_as_float(rr[0]) + __uint_as_float(rr[1]); }
    const float sc = (mp == 0 ? 1.0f : -lam) * __builtin_amdgcn_rcpf(lsum);
    LAS f32x4* xb = (LAS f32x4*)(lds + X_OFF) + qw * 1024 + lane;
    if (mp == 1) {
#pragma unroll
        for (int i = 0; i < 4; ++i)
#pragma unroll
            for (int rg = 0; rg < 4; ++rg) xb[(i * 4 + rg) * 64] = (f32x4){o[i][4 * rg] * sc, o[i][4 * rg + 1] * sc, o[i][4 * rg + 2] * sc, o[i][4 * rg + 3] * sc};
    }
    __syncthreads();
    if (mp == 0) {
        float ssq = 0.f;
#pragma unroll
        for (int i = 0; i < 4; ++i)
#pragma unroll
            for (int rg = 0; rg < 4; ++rg) { const f32x4 t = xb[(i * 4 + rg) * 64];
#pragma unroll
                for (int e = 0; e < 4; ++e) { const float v = o[i][4 * rg + e] * sc + t[e]; o[i][4 * rg + e] = v; ssq += v * v; } }
        { const auto rr = __builtin_amdgcn_permlane32_swap(__float_as_uint(ssq), __float_as_uint(ssq), false, false); ssq = __uint_as_float(rr[0]) + __uint_as_float(rr[1]); }
        const float rs = __builtin_amdgcn_rsqf(ssq * (1.f / 128.f) + SUBLN_EPS) * one_m_li;
        LAS unsigned char* yb = lds + Y_OFF + qw * (32 * YSTR);
#pragma unroll
        for (int i = 0; i < 4; ++i)
#pragma unroll
            for (int rg = 0; rg < 4; ++rg)
                *(LAS u32x2*)(yb + l32 * YSTR + (32 * i + 8 * rg + 4 * hi) * 2) = (u32x2){cvt_pk_bf16(o[i][4 * rg] * rs, o[i][4 * rg + 1] * rs), cvt_pk_bf16(o[i][4 * rg + 2] * rs, o[i][4 * rg + 3] * rs)};
    }
    __syncthreads();
    {
        const LAS unsigned char* yb = lds + Y_OFF + fw * (32 * YSTR);
#pragma unroll
        for (int i = 0; i < 4; ++i) {
            const int q = 16 * fh + 4 * i + (lane >> 4);
            const u32x4 yv = *(const LAS u32x4*)(yb + q * YSTR + pc * 16);
            const size_t off = (rowbase + q0 + 32 * fw + q) * 1024 + hd * 128 + 8 * pc;
            const u32x4 zv = zpre[i];
            u32x4 w;
            w.x = cvt_pk_bf16(bf_lo(yv.x) * g0.x * silu_f(bf_lo(zv.x)), bf_hi(yv.x) * g0.y * silu_f(bf_hi(zv.x)));
            w.y = cvt_pk_bf16(bf_lo(yv.y) * g0.z * silu_f(bf_lo(zv.y)), bf_hi(yv.y) * g0.w * silu_f(bf_hi(zv.y)));
            w.z = cvt_pk_bf16(bf_lo(yv.z) * g1.x * silu_f(bf_lo(zv.z)), bf_hi(yv.z) * g1.y * silu_f(bf_hi(zv.z)));
            w.w = cvt_pk_bf16(bf_lo(yv.w) * g1.z * silu_f(bf_lo(zv.w)), bf_hi(yv.w) * g1.w * silu_f(bf_hi(zv.w)));
            *(u32x4*)(Ob + off) = w;
        }
    }
    __syncthreads();
}
template <int VAR> __device__ __forceinline__ void attn_phase(unsigned char* ws, bf16_t* Ob, const bf16_t* Zb, const float* lamvec, const float* subln, float lam_init, LAS unsigned char* lds, int G, int vcu) {
    const int lane = threadIdx.x & 63;
    const float pa = wave_sum(lamvec[lane] * lamvec[64 + lane]), pb = wave_sum(lamvec[128 + lane] * lamvec[192 + lane]);
    const float lam = __expf(pa) - __expf(pb) + lam_init;
    const bf16_t* QO = (const bf16_t*)(ws + WS_H5 + 4 * SLOT); const bf16_t* Kb = (const bf16_t*)(ws + WS_H5 + 2 * SLOT); const bf16_t* Vt = (const bf16_t*)(ws + WS_H5 + 3 * SLOT);
    if (G == 256) {
        const int x = vcu >> 5, j = vcu & 31, g4 = j >> 3, p = j & 7;
#define UBH(i) (x * 16 + ((i) >> 1) * 4 + g4)
#define UQB(i) (((i) & 1) ? p : 15 - p)
        Pref pf; attn_prefetch(pf, UBH(0) >> 3, UBH(0) & 7, UQB(0), QO, Kb, Vt);
        for (int i = 0; i < 8; ++i) { const int bh = UBH(i), qb = UQB(i), nbh = UBH(i + 1), nqb = UQB(i + 1);
            attn_unit<VAR>(pf, i + 1 < 8, nbh >> 3, nbh & 7, nqb, bh >> 3, bh & 7, qb, QO, Ob, Kb, Vt, Zb, subln, lam, 1.0f - lam_init, lds); }
#undef UBH
#undef UQB
    } else {
        Pref pf; if (vcu < 2048) attn_prefetch(pf, vcu >> 7, (vcu >> 4) & 7, vcu & 15, QO, Kb, Vt);
        for (int u = vcu; u < 2048; u += G) { const int nu = u + G;
            attn_unit<VAR>(pf, nu < 2048, nu >> 7, (nu >> 4) & 7, nu & 15, u >> 7, (u >> 4) & 7, u & 15, QO, Ob, Kb, Vt, Zb, subln, lam, 1.0f - lam_init, lds); }
    }
}
}


#define XB_TMO      128
#define XB_XCNT(j)  (256  + 64 * (j))
#define XB_XSUB(j)  (1280 + 64 * (j))
#define XB_XGEN(j)  (2304 + 64 * (j))
#define XB_TOP      3328
#define XB_TOPGEN   3392
#define XCD_BAR_WORDS 3456
#define XB_SPIN_CAP (1u << 18)
__device__ __forceinline__ unsigned xb_ld(unsigned* p)              { return __hip_atomic_load(p, __ATOMIC_RELAXED, __HIP_MEMORY_SCOPE_AGENT); }
__device__ __forceinline__ unsigned xb_add(unsigned* p, unsigned v) { return __hip_atomic_fetch_add(p, v, __ATOMIC_RELAXED, __HIP_MEMORY_SCOPE_AGENT); }
__device__ __forceinline__ unsigned xb_xcc_id() { return (unsigned)__builtin_amdgcn_s_getreg((3 << 11) | 20) & 0xFu; }
#define XB_SPIN(cond, bar) do { unsigned _sp = 0; while (cond) { __builtin_amdgcn_s_sleep(1); \
    if ((++_sp & 255u) == 0u) { if (xb_ld(&(bar)[XB_TMO])) break; if (_sp > XB_SPIN_CAP) { atomicAdd(&(bar)[XB_TMO], 1u); break; } } } } while (0)
struct XcdBarrier { unsigned* bar; unsigned x; volatile LAS unsigned* st; };
__device__ __forceinline__ XcdBarrier xcd_barrier_post(unsigned* bar, volatile LAS unsigned* st) {
    XcdBarrier b; b.bar = bar; b.x = xb_xcc_id(); b.st = st;
    if (threadIdx.x == 0) (void)xb_add(&bar[XB_XCNT(b.x)], 1u);
    return b;
}
__device__ __forceinline__ void xcd_barrier_complete(unsigned* bar, unsigned x, unsigned& nloc, unsigned& nx) {
    const unsigned G = gridDim.x * gridDim.y * gridDim.z;
    unsigned sum, cnt, mine, sp = 0u;
    for (;;) {
        sum = 0u; cnt = 0u; mine = 0u;
#pragma unroll
        for (unsigned j = 0; j < 16; ++j) { const unsigned c = xb_ld(&bar[XB_XCNT(j)]); sum += c; cnt += (c > 0u) ? 1u : 0u; mine = (j == x) ? c : mine; }
        if (sum == G) break;
        __builtin_amdgcn_s_sleep(1);
        if ((++sp & 255u) == 0u) { if (xb_ld(&bar[XB_TMO])) break; if (sp > XB_SPIN_CAP) { atomicAdd(&bar[XB_TMO], 1u); break; } }
    }
    nloc = mine > 0u ? mine : 1u; nx = cnt > 0u ? cnt : 1u;
}
__device__ __forceinline__ void xcd_barrier(const XcdBarrier& b) {
    asm volatile("s_waitcnt vmcnt(0)" ::: "memory");
    __syncthreads();
    if (threadIdx.x == 0) {
        unsigned* bar = b.bar;
        __builtin_amdgcn_s_waitcnt(0);
        unsigned nloc = b.st[0], nx = b.st[1];
        if (nloc == 0u) { xcd_barrier_complete(bar, b.x, nloc, nx); b.st[0] = nloc; b.st[1] = nx; }
        const unsigned old = xb_add(&bar[XB_XSUB(b.x)], 1u);
        const unsigned gen = old / nloc;
        if (old + 1u == (gen + 1u) * nloc) {
            __builtin_amdgcn_fence(__ATOMIC_RELEASE, "agent");
            asm volatile("s_waitcnt vmcnt(0)" ::: "memory");
            const unsigned og = xb_add(&bar[XB_TOP], 1u);
            const unsigned tg = og / nx;
            if (og + 1u == (tg + 1u) * nx) xb_add(&bar[XB_TOPGEN], 1u);
            else XB_SPIN(xb_ld(&bar[XB_TOPGEN]) == tg, bar);
            __builtin_amdgcn_fence(__ATOMIC_ACQUIRE, "agent");
            xb_add(&bar[XB_XGEN(b.x)], 1u);
            asm volatile("s_waitcnt vmcnt(0)" ::: "memory");
        } else {
            XB_SPIN(xb_ld(&bar[XB_XGEN(b.x)]) == gen, bar);
            __builtin_amdgcn_fence(__ATOMIC_ACQUIRE, "agent");
            asm volatile("s_waitcnt vmcnt(0)" ::: "memory");
        }
    }
    __syncthreads();
}

__global__ void __launch_bounds__(512) fwd_megakernel(Args a) {
    extern __shared__ __attribute__((aligned(16))) unsigned char lds_raw[];
    LAS unsigned char* lds = (LAS unsigned char*)lds_raw;
    cg::grid_group grid = cg::this_grid();
    const int G = gridDim.x, bx = blockIdx.x;
    const int vcu = (G % 8 == 0) ? (bx % 8) * (G / 8) + bx / 8 : bx;
    unsigned char* ws = a.ws;
    const int lo = a.ph_lo, hi = a.ph_hi;
    if (threadIdx.x < 64) ((LAS unsigned*)(lds + LDS_MISC))[threadIdx.x] = 0u;
    __syncthreads();
    XcdBarrier xbar = xcd_barrier_post((unsigned*)(ws + WS_CTL), (volatile LAS unsigned*)(lds + LDS_MISC));
    bf16_t* H5 = (bf16_t*)(ws + WS_H5);
    const float* ADA = (const float*)(ws + WS_ADA); const float* KVADA = (const float*)(ws + WS_KVADA);
    bf16_t* GW16 = (bf16_t*)(ws + WS_GW); float* GW32 = (float*)(ws + WS_GW);
    bf16_t* OUT16 = (bf16_t*)a.out;
#ifndef PROBE_VAR
#define PROBE9
#define PROBE13
#else
#define PROBE9 att::attn_phase<PROBE_VAR>(ws, OUT16 + (size_t)M * 1024, OUT16, a.in[15], a.in[16], a.lam_init[0], lds, G, vcu);
#define PROBE13 att::attn_phase<PROBE_VAR>(ws, OUT16 + (size_t)M * 1024, OUT16, a.in[15] + 256, a.in[16] + 128, a.lam_init[1], lds, G, vcu);
#endif
#define IN(k) (lo <= (k) && (k) < hi)
#define SEAM(k) do { if ((k) + 1 < hi) { if (hi > 1000) grid.sync(); else xcd_barrier(xbar); } } while (0)
    if (IN(0)) { phase_p0a(a, lds, G, vcu, true, 8192, 11264); SEAM(0); }
    if (IN(1)) {
        { SchedFold S{ws, G, vcu}; pg8::gemm_phase(lds, 512, S); }
        phase_p0a(a, lds, G, vcu, false, 0, 8192);
        __syncthreads();
        phase_e_pool<false>(a.in[0], nullptr, nullptr, nullptr, nullptr, ADA + 0 * 16 * 3072, a.in[4] + 0 * D, H5, lds, G, vcu);
        SEAM(1);
    }
    if (IN(2)) { SchedA1 S{ws, OUT16, a.in[8] + 0 * 2048, 0, G, vcu}; pg8::gemm_phase(lds, 1024, S); SEAM(2); }
    if (IN(3)) { SchedN1024 S{OUT16, (const bf16_t*)(ws + WS_WOUT), GW16, 2048, G, vcu}; pg8::gemm_phase(lds, 2048, S); SEAM(3); }
    if (IN(4)) { phase_e_pool<true>(a.in[0], GW16, a.out, ADA + 0 * 16 * 3072, a.in[5] + 0 * D, ADA + 1 * 16 * 3072, a.in[4] + 1 * D, H5, lds, G, vcu); SEAM(4); }
    if (IN(5)) { SchedA1 S{ws, GW16, a.in[8] + 1 * 2048, 1, G, vcu}; pg8::gemm_phase(lds, 1024, S); SEAM(5); }
    if (IN(6)) { SchedN1024 S{GW16, (const bf16_t*)(ws + WS_WOUT) + (size_t)1024 * 2048, H5 + (size_t)4 * M * 1024, 2048, G, vcu}; pg8::gemm_phase(lds, 2048, S); SEAM(6); }
    if (IN(7)) { phase_e_rows<true, true>(a.out, H5 + (size_t)4 * M * 1024, GW32, ADA + 1 * 16 * 3072, a.in[5] + 1 * D, ADA + 2 * 16 * 3072, a.in[4] + 2 * D, H5,
                              KVADA, a.in[10], H5 + (size_t)1 * M * 1024, G, vcu); SEAM(7); }
    if (IN(8)) { SchedB1 S{ws, (const bf16_t*)(ws + WS_WBIN), OUT16, 1, G, vcu}; pg8::gemm_phase(lds, 1024, S); SEAM(8); }
    if (IN(9)) { att::attn_phase<0>(ws, H5, OUT16, a.in[15], a.in[16], a.lam_init[0], lds, G, vcu); PROBE9 SEAM(9); }
    if (IN(10)) { SchedN1024 S{H5, (const bf16_t*)(ws + WS_WBOUT), OUT16 + (size_t)M * 1024, 1024, G, vcu}; pg8::gemm_phase(lds, 1024, S); SEAM(10); }
    if (IN(11)) { phase_e_rows<true, true>(GW32, OUT16 + (size_t)M * 1024, GW32, ADA + 2 * 16 * 3072, a.in[5] + 2 * D, ADA + 3 * 16 * 3072, a.in[4] + 3 * D, H5,
                               nullptr, nullptr, nullptr, G, vcu); SEAM(11); }
    if (IN(12)) { SchedB1 S{ws, (const bf16_t*)(ws + WS_WBIN) + (size_t)2048 * 1024, OUT16, 0, G, vcu}; pg8::gemm_phase(lds, 1024, S); SEAM(12); }
    if (IN(13)) { att::attn_phase<0>(ws, H5, OUT16, a.in[15] + 256, a.in[16] + 128, a.lam_init[1], lds, G, vcu); PROBE13 SEAM(13); }
    if (IN(14)) { SchedN1024 S{H5, (const bf16_t*)(ws + WS_WBOUT) + (size_t)1024 * 1024, H5 + (size_t)1 * M * 1024, 1024, G, vcu}; pg8::gemm_phase(lds, 1024, S); SEAM(14); }
    if (IN(15)) { phase_e_rows<true, false>(GW32, H5 + (size_t)1 * M * 1024, a.out, ADA + 3 * 16 * 3072, a.in[5] + 3 * D, nullptr, nullptr, nullptr,
                               nullptr, nullptr, nullptr, G, vcu); }
#undef IN
#undef SEAM
}

#ifndef MK_PER_PHASE
#define MK_PER_PHASE 0
#endif

extern "C" void kernel_launch(void* const* d_in, const int* in_sizes, int n_in, void* d_out, int out_size, void* d_ws, size_t ws_size, hipStream_t stream) {
    static int grid = 0;
    if (grid == 0) {
        if (n_in != 18 || out_size != M * D || ws_size < WS_END) { fprintf(stderr, "kernel_launch: unexpected shapes (n_in %d out %d ws %zu)\n", n_in, out_size, ws_size); grid = -1; return; }
        int dev = 0, cus = 0, per_cu = 0;
        (void)hipGetDevice(&dev);
        (void)hipDeviceGetAttribute(&cus, hipDeviceAttributeMultiprocessorCount, dev);
        (void)hipFuncSetAttribute((const void*)fwd_megakernel, hipFuncAttributeMaxDynamicSharedMemorySize, LDS_BYTES);
        (void)hipOccupancyMaxActiveBlocksPerMultiprocessor(&per_cu, (const void*)fwd_megakernel, 512, LDS_BYTES);
        if (per_cu < 1) { fprintf(stderr, "kernel_launch: occupancy query says %d blocks/CU\n", per_cu); grid = -1; return; }
        grid = cus;
    }
    if (grid < 0) return;
    Args a{};
    for (int i = 0; i < 18; ++i) a.in[i] = (const float*)d_in[i];
    a.out = (float*)d_out; a.ws = (unsigned char*)d_ws;
    a.lam_init[0] = (float)(0.8 - 0.6 * std::exp(-0.3 * 2.0)); a.lam_init[1] = (float)(0.8 - 0.6 * std::exp(-0.3 * 3.0));
#if MK_PER_PHASE
    for (int p = 0; p < 16; ++p) { a.ph_lo = p; a.ph_hi = p + 1; hipLaunchKernelGGL(fwd_megakernel, dim3(grid), dim3(512), LDS_BYTES, stream, a); }
#else
    a.ph_lo = 0; a.ph_hi = 16;
    (void)hipMemsetAsync((char*)d_ws + WS_CTL, 0, CTL_BYTES, stream);
    void* args[] = {&a};
    hipError_t e = hipLaunchCooperativeKernel((const void*)fwd_megakernel, dim3(grid), dim3(512), args, LDS_BYTES, stream);
    if (e != hipSuccess) fprintf(stderr, "cooperative launch failed: %s (grid %d)\n", hipGetErrorString(e), grid);
#endif
}
```
